# Optimizing an MI355X kernel written in HIP

```python
import jax, jax.numpy as jnp
from jax import lax
import numpy as np

D_MODEL = 1024
BATCH = 8
SEQ = 2048
DEPTH = 2
DEC_BATCH = 128
DEC_SEQ = 4
PAST_LEN = 16384
PAGE_SIZE = 128

EXPAND = 2
EXPAND_WIDTH = EXPAND * D_MODEL
CONV_WIDTH = 3
POOL_WINDOWS = (2, 4, 8, 16)
N_POOL_GROUPS = len(POOL_WINDOWS)
POOL_GROUP_WIDTH = EXPAND_WIDTH // N_POOL_GROUPS
POOL_HIST = max(POOL_WINDOWS) - 1
N_MIXERS = 2
N_CONV_LAYERS = (DEPTH + 1) // 2
N_POOL_LAYERS = DEPTH // 2
RMS_EPS = 1e-6

kernel_name = "hybrid_shortconv_pool_decoder_step"


def rmsnorm(x, g):
    xf = x.astype(jnp.float32)
    r = lax.rsqrt(jnp.mean(xf * xf, axis=-1, keepdims=True) + RMS_EPS)
    return (xf * r * g.astype(jnp.float32)).astype(x.dtype)


def conv_mixer(h, hist, w_in, conv_w, conv_b, w_out):
    T = h.shape[1]
    proj = h @ w_in
    gb, gc, v, z = jnp.split(proj, 4, axis=-1)
    cv = gc * v
    full = jnp.concatenate([hist.astype(cv.dtype), cv], axis=1)
    conv = conv_b
    for k in range(CONV_WIDTH):
        conv = conv + full[:, k:k + T] * conv_w[k]
    y = gb * conv * jax.nn.silu(z)
    out = y @ w_out
    new_hist = full[:, -(CONV_WIDTH - 1):]
    return out, new_hist


def pool_mixer(h, hist, start_pos, w_in, w_grp, scale, w_out):
    b, T, _ = h.shape
    proj = h @ w_in
    u, z = jnp.split(proj, 2, axis=-1)
    full = jnp.concatenate([hist.astype(u.dtype), u], axis=1)
    fullf = full.astype(jnp.float32)
    cs = jnp.concatenate([jnp.zeros((b, 1, EXPAND_WIDTH), jnp.float32),
                          jnp.cumsum(fullf, axis=1)], axis=1)
    P = POOL_HIST
    pos = (start_pos + jnp.arange(T)).astype(jnp.float32)
    diffs = []
    for g, w in enumerate(POOL_WINDOWS):
        sl = slice(g * POOL_GROUP_WIDTH, (g + 1) * POOL_GROUP_WIDTH)
        win = cs[:, P + 1:P + 1 + T, sl] - cs[:, P + 1 - w:P + 1 - w + T, sl]
        cnt = jnp.minimum(jnp.float32(w), pos + 1.0)
        diffs.append(win / cnt[None, :, None] - fullf[:, P:, sl])
    pooled = jnp.stack(diffs, axis=2).astype(u.dtype)
    mixed = jnp.einsum('btgc,gcd->btgd', pooled, w_grp).reshape(b, T, EXPAND_WIDTH)
    y = mixed * scale * jax.nn.silu(z)
    out = y @ w_out
    new_hist = full[:, -P:]
    return out, new_hist


def _stack(lst, b, rows):
    if lst:
        return jnp.stack(lst)
    return jnp.zeros((0, b, rows, EXPAND_WIDTH), jnp.float32)


def trunk(x, conv_hist, pool_hist, start_pos, norm_g, final_norm_g,
          conv_w_in, conv_w, conv_b, conv_w_out,
          pool_w_in, pool_w_grp, pool_scale, pool_w_out):
    b = x.shape[0]
    new_conv, new_pool = [], []
    ia, ib = 0, 0
    for i in range(DEPTH):
        hn = rmsnorm(x, norm_g[i])
        if i % N_MIXERS == 0:
            out, nh = conv_mixer(hn, conv_hist[ia], conv_w_in[ia], conv_w[ia],
                                 conv_b[ia], conv_w_out[ia])
            new_conv.append(nh)
            ia += 1
        else:
            out, nh = pool_mixer(hn, pool_hist[ib], start_pos, pool_w_in[ib],
                                 pool_w_grp[ib], pool_scale[ib], pool_w_out[ib])
            new_pool.append(nh)
            ib += 1
        x = x + out
    return (rmsnorm(x, final_norm_g), _stack(new_conv, b, CONV_WIDTH - 1),
            _stack(new_pool, b, POOL_HIST))


def setup_inputs(seed: int = 0) -> dict:
    key = jax.random.key(seed)
    ks = jax.random.split(key, 14)
    D, E, Gc = D_MODEL, EXPAND_WIDTH, POOL_GROUP_WIDTH
    nrm = jax.random.normal
    return {
        "x_prompt": nrm(ks[0], (BATCH, SEQ, D), jnp.float32),
        "x_sample": nrm(ks[1], (DEC_BATCH, DEC_SEQ, D), jnp.float32),
        "state_conv": nrm(ks[2], (N_CONV_LAYERS, DEC_BATCH, CONV_WIDTH - 1, E), jnp.float32),
        "state_pool": nrm(ks[3], (N_POOL_LAYERS, DEC_BATCH, POOL_HIST, E), jnp.float32),
        "norm_g": 1.0 + 0.02 * nrm(ks[4], (DEPTH, D), jnp.float32),
        "final_norm_g": 1.0 + 0.02 * nrm(ks[5], (D,), jnp.float32),
        "conv_w_in": nrm(ks[6], (N_CONV_LAYERS, D, 4 * E), jnp.float32) * D ** -0.5,
        "conv_w": nrm(ks[7], (N_CONV_LAYERS, CONV_WIDTH, E), jnp.float32) * CONV_WIDTH ** -0.5,
        "conv_b": 0.02 * nrm(ks[8], (N_CONV_LAYERS, E), jnp.float32),
        "conv_w_out": nrm(ks[9], (N_CONV_LAYERS, E, D), jnp.float32) * E ** -0.5,
        "pool_w_in": nrm(ks[10], (N_POOL_LAYERS, D, 2 * E), jnp.float32) * D ** -0.5,
        "pool_w_grp": nrm(ks[11], (N_POOL_LAYERS, N_POOL_GROUPS, Gc, Gc), jnp.float32) * Gc ** -0.5,
        "pool_scale": 1.0 + 0.02 * nrm(ks[12], (N_POOL_LAYERS, E), jnp.float32),
        "pool_w_out": nrm(ks[13], (N_POOL_LAYERS, E, D), jnp.float32) * E ** -0.5,
    }


def reference(x_prompt, x_sample, state_conv, state_pool, norm_g, final_norm_g,
              conv_w_in, conv_w, conv_b, conv_w_out,
              pool_w_in, pool_w_grp, pool_scale, pool_w_out):
    b = x_prompt.shape[0]
    conv_hist0 = jnp.zeros((N_CONV_LAYERS, b, CONV_WIDTH - 1, EXPAND_WIDTH), x_prompt.dtype)
    pool_hist0 = jnp.zeros((N_POOL_LAYERS, b, POOL_HIST, EXPAND_WIDTH), x_prompt.dtype)
    y_prompt, new_conv_prompt, new_pool_prompt = trunk(
        x_prompt, conv_hist0, pool_hist0, 0, norm_g, final_norm_g,
        conv_w_in, conv_w, conv_b, conv_w_out,
        pool_w_in, pool_w_grp, pool_scale, pool_w_out)
    y_sample, new_conv_sample, new_pool_sample = trunk(
        x_sample, state_conv, state_pool, PAST_LEN, norm_g, final_norm_g,
        conv_w_in, conv_w, conv_b, conv_w_out,
        pool_w_in, pool_w_grp, pool_scale, pool_w_out)
    return (y_prompt, y_sample, new_conv_prompt, new_conv_sample,
            new_pool_prompt, new_pool_sample)
```

```cpp
#include <hip/hip_runtime.h>
#include <cstdio>
#include <cstdint>

#define LAS __attribute__((address_space(3)))
#define GAS __attribute__((address_space(1)))
typedef unsigned short bf16_t;
typedef short bf16x8 __attribute__((ext_vector_type(8)));
typedef float f32x4 __attribute__((ext_vector_type(4)));
typedef unsigned u32x4 __attribute__((ext_vector_type(4)));
typedef unsigned u32x2 __attribute__((ext_vector_type(2)));

constexpr int D = 1024, E = 2048, NB = 8, SEQ = 2048, DB = 128, DSEQ = 4;
constexpr int MP = NB * SEQ, MS = DB * DSEQ, M = MP + MS;
constexpr int N1 = 4 * E, N3 = 2 * E, GC = 512, PH = 15;
constexpr float EPS = 1e-6f;
constexpr size_t O_Y = 0, O_NCP = (size_t)M * D, O_NCS = O_NCP + (size_t)NB * 2 * E, O_NPP = O_NCS + (size_t)DB * 2 * E, O_NPS = O_NPP + (size_t)NB * PH * E;
constexpr size_t MiB = 1u << 20;
constexpr size_t WS_CTL = 0, WS_W4T = 1 * MiB, WS_W5T = 3 * MiB, WS_RS0 = 7 * MiB, WS_W3T = 8 * MiB, WS_XB = 16 * MiB, WS_SS1 = 49 * MiB;
constexpr size_t WS_HV = 53 * MiB, WS_PV = 69 * MiB;
constexpr size_t WS_B = 86 * MiB;
constexpr size_t WS_W1T = 152 * MiB;
constexpr size_t WS_HCV = 168 * MiB, WS_PGB = 171 * MiB, WS_PCV = 174 * MiB, WS_SCV = 177 * MiB, WS_SGB = 181 * MiB;
constexpr size_t WS_WUB = 185 * MiB;
constexpr size_t WS_W3U = 189 * MiB;
constexpr size_t WS_SPB = 193 * MiB;
constexpr size_t WS_HP = 201 * MiB;
constexpr size_t WS_SLAB = 217 * MiB;
constexpr size_t WS_PSZ = 233 * MiB;
constexpr size_t WS_SV = 242 * MiB, WS_SSZ = 246 * MiB;
constexpr size_t WS_W2T = 248 * MiB;
constexpr size_t WS_END = 252 * MiB;
constexpr int NRUN = MP / 128;
static_assert(WS_PV + (size_t)NRUN * 16 * E * 4 <= WS_B && WS_HV + (size_t)NRUN * PH * E * 4 <= WS_PV && WS_XB + (size_t)M * D * 2 <= WS_SS1 && WS_B + (size_t)M * E * 2 <= WS_W1T, "ws map 1");
static_assert(WS_SGB + (size_t)MS * E * 4 <= WS_WUB && WS_HP + (size_t)2048 * E * 4 <= WS_SLAB && WS_SLAB + (size_t)8 * MS * D * 4 <= WS_PSZ && WS_PSZ + (size_t)NRUN * 16 * E * 2 <= WS_SV && WS_SSZ + (size_t)MS * E * 2 <= WS_W2T, "ws map 2");

namespace pg8 {
constexpr int BM = 256, BK = 64, HALF = 128, HTB = HALF * BK * 2, STAGE_BYTES = 8 * HTB, NXCD = 8, WGM = 8;
__host__ __device__ __forceinline__ int lds_byte(int r, int c) { const int st = (r >> 4) * 2 + (c >> 5), rr = r & 15, cc = c & 31, ob = rr * 64 + cc * 2; return st * 1024 + (ob ^ (((ob >> 9) & 1) << 5)); }
__host__ __device__ __forceinline__ void stage_rc(int b, int& R, int& C) { const int st = b / 1024, sb = b % 1024, swz = sb ^ (((sb >> 9) & 1) << 5); R = (st >> 1) * 16 + swz / 64; C = (st & 1) * 32 + (swz % 64) / 2; }

struct Unit { int pm, pn, slot; };
struct Gemm { const bf16_t* A; const bf16_t* Bt; int M, N, K, lda, agshift, agstride, ldb, bgshift, bgstride; };

struct StaticOrder {
    int nM, nN, nwg, G, c;
    __device__ void init(int M_, int N_, int G_, int c_) { nM = M_ / BM; nN = N_ / BM; nwg = nM * nN; G = G_; c = c_; }
    __device__ bool next(int i, Unit& u) const {
        const long L = (long)i * G + c; if (L >= nwg) return false;
        int wgid = (int)L; { const int q = nwg / NXCD, r = nwg % NXCD, xcd = wgid % NXCD, off = wgid / NXCD; wgid = (xcd < r ? xcd * (q + 1) : r * (q + 1) + (xcd - r) * q) + off; }
        const int nig = WGM * nN, gid = wgid / nig, fm = gid * WGM, gsz = (nM - fm) < WGM ? (nM - fm) : WGM;
        u.pm = fm + ((wgid % nig) % gsz); u.pn = (wgid % nig) / gsz; u.slot = i & 1; return true;
    }
    __device__ __forceinline__ void a_ready(const Unit&) const {}
    __device__ __forceinline__ void done(const Unit&, int) const {}
};

__device__ __forceinline__ unsigned cvt_pk_bf16(float lo, float hi) { unsigned r; asm("v_cvt_pk_bf16_f32 %0, %1, %2" : "=v"(r) : "v"(lo), "v"(hi)); return r; }

template <class Epi, class Sched, bool ALIGN_EPI, bool SP2, int ROWPERM>
__device__ __forceinline__ void gemm_phase(LAS unsigned char* lds, const Gemm g, const Sched& S, const Epi& E) {
    int tid = threadIdx.x; asm volatile("" : "+v"(tid));
    const int wid = __builtin_amdgcn_readfirstlane(tid >> 6), lane = tid & 63, wr = wid >> 2, wc = wid & 3, fr = lane & 15, fq = lane >> 4;
    const int K = g.K, nt = K / BK, lda = g.lda;
    unsigned voffA[2], voffB[2];
#pragma unroll
    for (int i = 0; i < 2; ++i) { int R, C; stage_rc(tid * 16 + i * 8192, R, C); const int Ra = ROWPERM == 2 ? ((R >> 4) * 2048 + 2032 + (R & 15)) : ROWPERM == 1 ? (128 * ((R >> 6) & 1) + 8 * (R & 15) + ((R >> 4) & 3)) : R;
        voffA[i] = (unsigned)(Ra * lda + C) * 2u; voffB[i] = (unsigned)(R * g.ldb + C) * 2u; }
    const size_t kstep = (size_t)(BK * 2);
    const size_t tstepA = (size_t)BM * lda * 2, hstepA = ROWPERM == 2 ? (size_t)0 : ROWPERM == 1 ? (size_t)4 * lda * 2 : (size_t)HALF * lda * 2, hstepB = (size_t)HALF * g.ldb * 2;
    const unsigned ldsw = (unsigned)wid * 1024u;
    const int aoff = lds_byte(wr * 64 + fr, fq * 8), boff = lds_byte(wc * 32 + fr, fq * 8);
#define PG8_UA(u) ((const char*)g.A + (size_t)(u).pm * tstepA + (size_t)(((u).pn >> g.agshift) * g.agstride) * 2)
#define PG8_UB(u) ((const char*)g.Bt + (size_t)(u).pn * 2 * hstepB + (size_t)(((u).pm >> g.bgshift) * g.bgstride) * 2)
#define PG8_SA(b, h) (((b) * 2 + (h)) * HTB)
#define PG8_SB(b, h) ((4 + (b) * 2 + (h)) * HTB)
#define PG8_STAGE(bufoff, gbase, voff) do { _Pragma("unroll") for (int _i = 0; _i < 2; ++_i) \
        __builtin_amdgcn_global_load_lds((const unsigned*)((const char*)(gbase) + (voff)[_i]), (LAS unsigned*)(lds + (bufoff) + ldsw + _i * 8192), 16, 0, 0); } while (0)
#define PG8_LDA(dst, b, h) do { _Pragma("unroll") for (int m = 0; m < 4; ++m) _Pragma("unroll") for (int k = 0; k < 2; ++k) dst[m][k] = *(const LAS bf16x8*)(lds + PG8_SA(b, h) + aoff + m * 2048 + k * 1024); } while (0)
#define PG8_LDB(dst, b, h) do { _Pragma("unroll") for (int n = 0; n < 2; ++n) _Pragma("unroll") for (int k = 0; k < 2; ++k) dst[n][k] = *(const LAS bf16x8*)(lds + PG8_SB(b, h) + boff + n * 2048 + k * 1024); } while (0)
#define PG8_MMA(ai, bj, At, Bt) do { __builtin_amdgcn_s_setprio(1); _Pragma("unroll") for (int m = 0; m < 4; ++m) _Pragma("unroll") for (int n = 0; n < 2; ++n) _Pragma("unroll") for (int k = 0; k < 2; ++k) \
        acc[ai][bj][m][n] = __builtin_amdgcn_mfma_f32_16x16x32_bf16(Bt[n][k], At[m][k], acc[ai][bj][m][n], 0, 0, 0); __builtin_amdgcn_s_setprio(0); } while (0)
#define PG8_WAIT_V(n) asm volatile("s_waitcnt vmcnt(" #n ")" ::: "memory")
#define PG8_WAIT_L(n) asm volatile("s_waitcnt lgkmcnt(" #n ")" ::: "memory")
#define PG8_BAR __builtin_amdgcn_s_barrier()
#define PG8_SCHED __builtin_amdgcn_sched_barrier(0)
    Unit cur, nxt; int ui = 0;
    if (!S.next(0, cur)) return;
    f32x4 acc[2][2][4][2];
#pragma unroll
    for (int a = 0; a < 2; ++a)
#pragma unroll
        for (int b = 0; b < 2; ++b)
#pragma unroll
            for (int m = 0; m < 4; ++m)
#pragma unroll
                for (int n = 0; n < 2; ++n) acc[a][b][m][n] = (f32x4){0.f, 0.f, 0.f, 0.f};
    bf16x8 At[4][2], B0[2][2], B1[2][2];
    const char* cA = PG8_UA(cur); const char* cB = PG8_UB(cur);
    S.a_ready(cur);
    if constexpr (SP2) {
        PG8_STAGE(PG8_SB(0, 0), cB, voffB); PG8_STAGE(PG8_SB(0, 1), cB + hstepB, voffB); PG8_STAGE(PG8_SA(0, 0), cA, voffA); PG8_STAGE(PG8_SA(0, 1), cA + hstepA, voffA);
        if (wr == 1) PG8_BAR;
        PG8_WAIT_V(2); PG8_BAR;
        PG8_STAGE(PG8_SB(1, 0), cB + kstep, voffB); PG8_STAGE(PG8_SA(1, 0), cA + kstep, voffA); PG8_STAGE(PG8_SB(1, 1), cB + hstepB + kstep, voffB);
        PG8_WAIT_V(6); PG8_BAR;
    } else {
        PG8_STAGE(PG8_SB(0, 0), cB, voffB); PG8_STAGE(PG8_SA(0, 0), cA, voffA); PG8_STAGE(PG8_SB(0, 1), cB + hstepB, voffB); PG8_STAGE(PG8_SA(0, 1), cA + hstepA, voffA);
        if (wr == 1) PG8_BAR;
        PG8_WAIT_V(4); PG8_BAR;
        PG8_STAGE(PG8_SB(1, 0), cB + kstep, voffB); PG8_STAGE(PG8_SA(1, 0), cA + kstep, voffA); PG8_STAGE(PG8_SB(1, 1), cB + hstepB + kstep, voffB);
        PG8_WAIT_V(6); PG8_BAR;
    }
    for (;;) {
        const bool has_next = S.next(ui + 1, nxt);
        const char* nA = has_next ? PG8_UA(nxt) : cA; const char* nB = has_next ? PG8_UB(nxt) : cB;
        for (int t = 0; t < nt; t += 2) {
            const bool last = (t == nt - 2);
            const char* a1 = cA + (size_t)(t + 1) * kstep;
            const char* a2 = last ? nA : cA + (size_t)(t + 2) * kstep; const char* b2 = last ? nB : cB + (size_t)(t + 2) * kstep;
            const char* a3 = a2 + kstep; const char* b3 = b2 + kstep;
            if (last && has_next) S.a_ready(nxt);
            if constexpr (SP2) {
            PG8_LDB(B0, 0, 0); PG8_LDB(B1, 0, 1); PG8_SCHED; PG8_LDA(At, 0, 0); PG8_STAGE(PG8_SA(1, 1), a1 + hstepA, voffA);
            PG8_WAIT_V(8); PG8_WAIT_L(0); PG8_BAR; PG8_MMA(0, 0, At, B0); PG8_MMA(0, 1, At, B1); PG8_BAR; PG8_SCHED;
            PG8_LDA(At, 0, 1); PG8_STAGE(PG8_SB(0, 0), b2, voffB); PG8_STAGE(PG8_SB(0, 1), b2 + hstepB, voffB); PG8_STAGE(PG8_SA(0, 0), a2, voffA);
            PG8_WAIT_V(8); PG8_WAIT_L(0); PG8_BAR; PG8_MMA(1, 0, At, B0); PG8_MMA(1, 1, At, B1); PG8_BAR; PG8_SCHED;
            PG8_LDB(B0, 1, 0); PG8_LDB(B1, 1, 1); PG8_SCHED; PG8_LDA(At, 1, 0); PG8_STAGE(PG8_SA(0, 1), a2 + hstepA, voffA);
            PG8_WAIT_V(8); PG8_WAIT_L(0); PG8_BAR; PG8_MMA(0, 0, At, B0); PG8_MMA(0, 1, At, B1); PG8_BAR; PG8_SCHED;
            PG8_LDA(At, 1, 1); PG8_STAGE(PG8_SB(1, 0), b3, voffB); PG8_STAGE(PG8_SB(1, 1), b3 + hstepB, voffB); PG8_STAGE(PG8_SA(1, 0), a3, voffA);
            PG8_WAIT_V(8); PG8_WAIT_L(0); PG8_BAR; PG8_MMA(1, 0, At, B0); PG8_MMA(1, 1, At, B1); PG8_BAR; PG8_SCHED;
            } else {
            PG8_LDB(B0, 0, 0); PG8_SCHED; PG8_LDA(At, 0, 0); PG8_STAGE(PG8_SA(1, 1), a1 + hstepA, voffA);
            PG8_WAIT_L(8); PG8_BAR; PG8_WAIT_L(0); PG8_MMA(0, 0, At, B0); PG8_BAR; PG8_SCHED;
            PG8_LDB(B1, 0, 1); PG8_STAGE(PG8_SB(0, 0), b2, voffB);
            PG8_BAR; PG8_WAIT_L(0); PG8_MMA(0, 1, At, B1); PG8_BAR;
            PG8_LDA(At, 0, 1); PG8_STAGE(PG8_SA(0, 0), a2, voffA);
            PG8_BAR; PG8_WAIT_L(0); PG8_MMA(1, 0, At, B0); PG8_BAR; PG8_SCHED;
            PG8_STAGE(PG8_SB(0, 1), b2 + hstepB, voffB);
            PG8_WAIT_V(6); PG8_BAR; PG8_MMA(1, 1, At, B1); PG8_BAR;
            PG8_LDB(B0, 1, 0); PG8_SCHED; PG8_LDA(At, 1, 0); PG8_STAGE(PG8_SA(0, 1), a2 + hstepA, voffA);
            PG8_WAIT_L(8); PG8_BAR; PG8_WAIT_L(0); PG8_MMA(0, 0, At, B0); PG8_BAR; PG8_SCHED;
            PG8_LDB(B1, 1, 1); PG8_STAGE(PG8_SB(1, 0), b3, voffB);
            PG8_BAR; PG8_WAIT_L(0); PG8_MMA(0, 1, At, B1); PG8_BAR;
            PG8_LDA(At, 1, 1); PG8_STAGE(PG8_SA(1, 0), a3, voffA);
            PG8_BAR; PG8_WAIT_L(0); PG8_MMA(1, 0, At, B0); PG8_BAR; PG8_SCHED;
            PG8_STAGE(PG8_SB(1, 1), b3 + hstepB, voffB);
            PG8_WAIT_V(6); PG8_BAR; PG8_MMA(1, 1, At, B1); PG8_BAR;
            }
        }
        if constexpr (ALIGN_EPI) { if (wr == 0) PG8_BAR; }
        E(acc, cur, wr, wc, fr, fq); S.done(cur, lane);
        if (!has_next) break;
#pragma unroll
        for (int a = 0; a < 2; ++a)
#pragma unroll
            for (int b = 0; b < 2; ++b)
#pragma unroll
                for (int m = 0; m < 4; ++m)
#pragma unroll
                    for (int n = 0; n < 2; ++n) acc[a][b][m][n] = (f32x4){0.f, 0.f, 0.f, 0.f};
        cur = nxt; cA = nA; cB = nB; ++ui;
        if constexpr (ALIGN_EPI) { if (wr == 1) PG8_BAR; }
    }
    PG8_WAIT_V(0);
    if constexpr (!ALIGN_EPI) { if (wr == 0) PG8_BAR; }
    PG8_BAR;
#undef PG8_UA
#undef PG8_UB
#undef PG8_SA
#undef PG8_SB
#undef PG8_STAGE
#undef PG8_LDA
#undef PG8_LDB
#undef PG8_MMA
#undef PG8_WAIT_V
#undef PG8_WAIT_L
#undef PG8_BAR
#undef PG8_SCHED
}
}

using pg8::Unit; using pg8::cvt_pk_bf16;
#define LDS_WAIT() asm volatile("s_waitcnt lgkmcnt(0)" ::: "memory")
__device__ __forceinline__ float sigm(float z) { return __builtin_amdgcn_rcpf(1.0f + __builtin_amdgcn_exp2f(-1.4426950408889634f * z)); }
__device__ __forceinline__ float bflo(unsigned w) { return __builtin_bit_cast(float, w << 16); }
__device__ __forceinline__ float bfhi(unsigned w) { return __builtin_bit_cast(float, w & 0xffff0000u); }
__device__ __forceinline__ void bf8_to_f32(const u32x4 w, float (&f)[8]) { f[0] = bflo(w.x); f[1] = bfhi(w.x); f[2] = bflo(w.y); f[3] = bfhi(w.y); f[4] = bflo(w.z); f[5] = bfhi(w.z); f[6] = bflo(w.w); f[7] = bfhi(w.w); }
__device__ __forceinline__ u32x4 f32_to_bf8(const float (&f)[8]) { u32x4 w; w.x = cvt_pk_bf16(f[0], f[1]); w.y = cvt_pk_bf16(f[2], f[3]); w.z = cvt_pk_bf16(f[4], f[5]); w.w = cvt_pk_bf16(f[6], f[7]); return w; }
__device__ __forceinline__ float dpp_add(float v, const int ctrl_sel) {
    const int x = __builtin_bit_cast(int, v); int y;
    if (ctrl_sel == 0) y = __builtin_amdgcn_update_dpp(0, x, 0xB1, 0xf, 0xf, true);
    else if (ctrl_sel == 1) y = __builtin_amdgcn_update_dpp(0, x, 0x4E, 0xf, 0xf, true);
    else if (ctrl_sel == 2) y = __builtin_amdgcn_update_dpp(0, x, 0x141, 0xf, 0xf, true);
    else y = __builtin_amdgcn_update_dpp(0, x, 0x140, 0xf, 0xf, true);
    return v + __builtin_bit_cast(float, y);
}
__device__ __forceinline__ float wave_sum(float v) {
    v = dpp_add(v, 0); v = dpp_add(v, 1); v = dpp_add(v, 2); v = dpp_add(v, 3);
    const int x = __builtin_bit_cast(int, v);
    const float a = __builtin_bit_cast(float, __builtin_amdgcn_readlane(x, 0)), b = __builtin_bit_cast(float, __builtin_amdgcn_readlane(x, 16));
    const float c = __builtin_bit_cast(float, __builtin_amdgcn_readlane(x, 32)), d = __builtin_bit_cast(float, __builtin_amdgcn_readlane(x, 48));
    return (a + b) + (c + d);
}

__device__ __forceinline__ int dest_row(int kind, int n) {
    if (kind == 0) { const int part = n >> 11, e = n & 2047, pn = e >> 6, el = e & 63; const int cg = (el >> 2) & 3, sg = ((cg & 1) << 1) | (cg >> 1); return pn * 256 + (part >> 1) * 128 + (el >> 4) * 32 + (part & 1) * 16 + sg * 4 + (el & 3); }
    if (kind == 1) { const int part = n >> 11, e = n & 2047, pn = e >> 7, el = e & 127; return pn * 256 + part * 128 + (el >> 5) * 32 + ((el >> 2) & 1) * 16 + ((el >> 3) & 3) * 4 + (el & 3); }
    const int cl = n & 255; return (n & ~255) + (cl & 0xE0) + ((cl >> 2) & 1) * 16 + ((cl >> 3) & 3) * 4 + (cl & 3);
}
__device__ __forceinline__ void prompt_unit(int L, int nN, Unit& u) {
    const int per = 8 * nN, w = (L & 7) * per + (L >> 3), r = w % per;
    u.pm = (w / per) * 8 + (r & 7); u.pn = r >> 3;
}
__device__ __forceinline__ void wait_count(const unsigned* cnt, unsigned need) {
    if (threadIdx.x < 64) {
        unsigned sp = 0;
        while ((unsigned)__builtin_amdgcn_readfirstlane(__hip_atomic_load(cnt, __ATOMIC_RELAXED, __HIP_MEMORY_SCOPE_AGENT)) < need) { __builtin_amdgcn_s_sleep(2); if (++sp > (1u << 21)) break; }
        __builtin_amdgcn_fence(__ATOMIC_ACQUIRE, "agent");
        asm volatile("s_waitcnt vmcnt(0)" ::: "memory");
    }
    asm volatile("" ::: "memory"); __builtin_amdgcn_s_barrier(); asm volatile("" ::: "memory");
}
__device__ __forceinline__ void count_in(unsigned* cnt, int lane) {
    asm volatile("s_waitcnt vmcnt(0)" ::: "memory");
    if (lane == 0) __hip_atomic_fetch_add(cnt, 1u, __ATOMIC_RELAXED, __HIP_MEMORY_SCOPE_AGENT);
}

typedef __amdgpu_buffer_rsrc_t rsrc_t;
__device__ __forceinline__ rsrc_t mk_rsrc(const void* p, unsigned bytes) { return __builtin_amdgcn_make_buffer_rsrc((void*)p, 0, bytes, 0x00020000); }
__device__ __forceinline__ void st16_wt(rsrc_t r, unsigned byte_off, u32x4 v) { __builtin_amdgcn_raw_buffer_store_b128(v, r, byte_off, 0, 16); }
__device__ __forceinline__ void st8_wt(void* p, u32x2 v) { __hip_atomic_store((unsigned long long*)p, __builtin_bit_cast(unsigned long long, v), __ATOMIC_RELAXED, __HIP_MEMORY_SCOPE_AGENT); }
__device__ __forceinline__ float dpp_shr1(float v) { return __builtin_bit_cast(float, __builtin_amdgcn_update_dpp(0, __builtin_bit_cast(int, v), 0x111, 0xf, 0xf, true)); }
__device__ __forceinline__ float dpp_shr2(float v) { return __builtin_bit_cast(float, __builtin_amdgcn_update_dpp(0, __builtin_bit_cast(int, v), 0x112, 0xf, 0xf, true)); }
__device__ __forceinline__ void st_pair(bf16_t* Y0, int t, int e0, int hi32, u32x2 a, u32x2 b) {
    const auto rx = __builtin_amdgcn_permlane32_swap(a.x, b.x, false, false), ry = __builtin_amdgcn_permlane32_swap(a.y, b.y, false, false);
    *(u32x4*)(Y0 + (size_t)(t + hi32) * E + (e0 - 4 * hi32)) = (u32x4){rx[0], ry[0], rx[1], ry[1]};
}
struct Epi1 {
    LAS unsigned char* tab; bf16_t* Y0; float* HCV; float* PGB; float* PCV; const float* st_conv; float* out;
    __device__ __forceinline__ void operator()(const f32x4 (&acc)[2][2][4][2], const Unit& u, int wr, int wc, int fr, int fq) const {
        const int cgq = ((fq & 1) << 1) | (fq >> 1);
        const int e0 = u.pn * 64 + wc * 16 + cgq * 4;
        const int t0 = u.pm * 256 + wr * 128 + fr * 8, hi32 = fq >> 1;
        const LAS unsigned char* tb = tab + (u.slot & 1) * 2048;
        const f32x4 ra = *(const LAS f32x4*)(tb + (wr * 128 + fr * 8) * 4), rb = *(const LAS f32x4*)(tb + (wr * 128 + fr * 8) * 4 + 16);
        f32x4 cv[8], g[8];
#pragma unroll
        for (int i = 0; i < 8; ++i) {
            const float r = i < 4 ? ra[i & 3] : rb[i & 3];
            const f32x4 gb = acc[i >> 2][0][i & 3][0] * r, gc = acc[i >> 2][0][i & 3][1] * r, v = acc[i >> 2][1][i & 3][0] * r, z = acc[i >> 2][1][i & 3][1] * r;
            cv[i] = gc * v;
#pragma unroll
            for (int j = 0; j < 4; ++j) g[i][j] = gb[j] * z[j] * sigm(z[j]);
        }
        const LAS f32x4* wp = (const LAS f32x4*)(tb + 1024 + (wc * 16 + cgq * 4) * 4);
        const f32x4 w0 = wp[0], w1 = wp[16], w2 = wp[32], bb = wp[48];
        if (u.pm >= MP / 256) {
            const int s0 = t0 - MP, b0 = s0 >> 2;
#pragma unroll
            for (int q = 0; q < 2; ++q) {
                const float* st = st_conv + ((size_t)(b0 + q) * 2) * E + e0;
                const f32x4 h0 = *(const f32x4*)st, h1 = *(const f32x4*)(st + E);
                u32x2 w[4];
#pragma unroll
                for (int k = 0; k < 4; ++k) { const int i = 4 * q + k;
                    const f32x4 cm2 = k >= 2 ? cv[i - 2] : (k == 0 ? h0 : h1), cm1 = k >= 1 ? cv[i - 1] : h1;
                    const f32x4 y = g[i] * (bb + w0 * cm2 + w1 * cm1 + w2 * cv[i]);
                    w[k].x = cvt_pk_bf16(y[0], y[1]); w[k].y = cvt_pk_bf16(y[2], y[3]); }
                st_pair(Y0, t0 + 4 * q, e0, hi32, w[0], w[1]); st_pair(Y0, t0 + 4 * q + 2, e0, hi32, w[2], w[3]);
                float* o = out + O_NCS + ((size_t)(b0 + q) * 2) * E + e0;
                *(f32x4*)o = cv[4 * q + 2]; *(f32x4*)(o + E) = cv[4 * q + 3];
            }
            return;
        }
        f32x4 hm2, hm1;
#pragma unroll
        for (int j = 0; j < 4; ++j) { hm2[j] = dpp_shr1(cv[6][j]); hm1[j] = dpp_shr1(cv[7][j]); }
#pragma unroll
        for (int i = 0; i < 8; i += 2) {
            u32x2 w[2];
#pragma unroll
            for (int k = 0; k < 2; ++k) { const int t = i + k;
                const f32x4 cm2 = t >= 2 ? cv[t - 2] : (t == 0 ? hm2 : hm1), cm1 = t >= 1 ? cv[t - 1] : hm1;
                const f32x4 y = g[t] * (bb + w0 * cm2 + w1 * cm1 + w2 * cv[t]);
                w[k].x = cvt_pk_bf16(y[0], y[1]); w[k].y = cvt_pk_bf16(y[2], y[3]); }
            if (i >= 2 || fr != 0) st_pair(Y0, t0 + i, e0, hi32, w[0], w[1]);
        }
        const int run = 2 * u.pm + wr;
        if (fr == 0) {
            *(f32x4*)(PGB + ((size_t)run * 2 + 0) * E + e0) = g[0]; *(f32x4*)(PGB + ((size_t)run * 2 + 1) * E + e0) = g[1];
            *(f32x4*)(PCV + ((size_t)run * 2 + 0) * E + e0) = cv[0]; *(f32x4*)(PCV + ((size_t)run * 2 + 1) * E + e0) = cv[1];
        }
        if (fr == 15) {
            *(f32x4*)(HCV + ((size_t)run * 2 + 0) * E + e0) = cv[6]; *(f32x4*)(HCV + ((size_t)run * 2 + 1) * E + e0) = cv[7];
            if ((run & 15) == 15) { *(f32x4*)(out + O_NCP + ((size_t)(run >> 4) * 2 + 0) * E + e0) = cv[6]; *(f32x4*)(out + O_NCP + ((size_t)(run >> 4) * 2 + 1) * E + e0) = cv[7]; }
        }
    }
};
template <bool SSQ> struct EpiRes {
    bf16_t* XB; float* ssp;
    __device__ __forceinline__ void operator()(const f32x4 (&acc)[2][2][4][2], const Unit& u, int wr, int wc, int fr, int fq) const {
        const int col0 = u.pn * 256 + wc * 32 + fq * 8;
        const rsrc_t rx = mk_rsrc(XB, (unsigned)((size_t)M * D * 2));
#pragma unroll
        for (int ai = 0; ai < 2; ++ai)
#pragma unroll
            for (int m = 0; m < 4; ++m) {
                const int row = u.pm * 256 + ai * 128 + wr * 64 + m * 16 + fr;
                float ss = 0.f;
#pragma unroll
                for (int bj = 0; bj < 2; ++bj) {
                    const size_t off = (size_t)row * D + col0 + bj * 128;
                    float x[8]; bf8_to_f32(*(const u32x4*)(XB + off), x);
                    const f32x4 a0 = acc[ai][bj][m][0], a1 = acc[ai][bj][m][1];
                    float v[8];
#pragma unroll
                    for (int j = 0; j < 4; ++j) { v[j] = x[j] + a0[j]; v[4 + j] = x[4 + j] + a1[j]; }
                    if (SSQ) ss += ((v[0] * v[0] + v[1] * v[1]) + (v[2] * v[2] + v[3] * v[3])) + ((v[4] * v[4] + v[5] * v[5]) + (v[6] * v[6] + v[7] * v[7]));
                    st16_wt(rx, (unsigned)(off * 2), f32_to_bf8(v));
                }
                if (SSQ) { ss += __shfl_xor(ss, 16); ss += __shfl_xor(ss, 32);
                    if (fq == 0) __hip_atomic_store(ssp + (size_t)row * 16 + u.pn * 4 + wc, ss, __ATOMIC_RELAXED, __HIP_MEMORY_SCOPE_AGENT); }
            }
    }
};
struct EpiG5 {
    const bf16_t* XB; float* xs; unsigned* cnt; const float* gfin; float* outy; LAS unsigned char* tab; LAS unsigned char* stage;
    __device__ __forceinline__ void operator()(const f32x4 (&acc)[2][2][4][2], const Unit& u, int wr, int wc, int fr, int fq) const {
        const int col0 = u.pn * 256 + wc * 32 + fq * 8;
        f32x4 v[2][4][2][2];
#pragma unroll
        for (int ai = 0; ai < 2; ++ai)
#pragma unroll
            for (int m = 0; m < 4; ++m) {
                const int row = u.pm * 256 + ai * 128 + wr * 64 + m * 16 + fr;
                float ss = 0.f;
#pragma unroll
                for (int bj = 0; bj < 2; ++bj) {
                    float x[8]; bf8_to_f32(*(const u32x4*)(XB + (size_t)row * D + col0 + bj * 128), x);
                    const f32x4 a0 = acc[ai][bj][m][0], a1 = acc[ai][bj][m][1];
                    f32x4 v0, v1;
#pragma unroll
                    for (int j = 0; j < 4; ++j) { v0[j] = x[j] + a0[j]; v1[j] = x[4 + j] + a1[j]; }
                    ss += ((v0[0] * v0[0] + v0[1] * v0[1]) + (v0[2] * v0[2] + v0[3] * v0[3])) + ((v1[0] * v1[0] + v1[1] * v1[1]) + (v1[2] * v1[2] + v1[3] * v1[3]));
                    v[ai][m][bj][0] = v0; v[ai][m][bj][1] = v1;
                }
                ss += __shfl_xor(ss, 16); ss += __shfl_xor(ss, 32);
                if (fq == 0) __hip_atomic_store(xs + (size_t)row * 16 + u.pn * 4 + wc, ss, __ATOMIC_RELAXED, __HIP_MEMORY_SCOPE_AGENT);
            }
        asm volatile("s_waitcnt vmcnt(0)" ::: "memory"); __builtin_amdgcn_s_barrier();
        if (threadIdx.x == 0) __hip_atomic_fetch_add(cnt + 64 * u.pm, 1u, __ATOMIC_RELAXED, __HIP_MEMORY_SCOPE_AGENT);
        LAS unsigned char* stg = stage + (wr * 4 + wc) * 16384;
#pragma unroll
        for (int m = 0; m < 4; ++m)
#pragma unroll
            for (int bj = 0; bj < 2; ++bj)
#pragma unroll
                for (int h = 0; h < 2; ++h) *(LAS f32x4*)(stg + (m * 16 + fr) * 256 + (((bj * 8 + fq * 2 + h) ^ fr) << 4)) = v[0][m][bj][h];
        wait_count(cnt + 64 * u.pm, 4u);
        { const int t = threadIdx.x;
          if (t < 256) { const f32x4* sp = (const f32x4*)(xs + ((size_t)u.pm * 256 + t) * 16);
              const f32x4 st = (sp[0] + sp[1]) + (sp[2] + sp[3]);
              *(LAS float*)(tab + t * 4) = rsqrtf(((st[0] + st[1]) + (st[2] + st[3])) * (1.0f / D) + EPS); } }
        asm volatile("s_waitcnt lgkmcnt(0)" ::: "memory"); __builtin_amdgcn_s_barrier(); asm volatile("" ::: "memory");
        const int lane = fq * 16 + fr, c = lane & 15, rq = lane >> 4;
        const int colL = u.pn * 256 + (c >> 3) * 128 + wc * 32 + (c & 7) * 4;
        const f32x4 gl = *(const f32x4*)(gfin + colL);
#pragma unroll
        for (int ai = 0; ai < 2; ++ai) {
            if (ai == 1) {
#pragma unroll
                for (int m = 0; m < 4; ++m)
#pragma unroll
                    for (int bj = 0; bj < 2; ++bj)
#pragma unroll
                        for (int h = 0; h < 2; ++h) *(LAS f32x4*)(stg + (m * 16 + fr) * 256 + (((bj * 8 + fq * 2 + h) ^ fr) << 4)) = v[1][m][bj][h];
            }
            asm volatile("s_waitcnt lgkmcnt(0)" ::: "memory");
#pragma unroll
            for (int k = 0; k < 16; ++k) {
                const int r = k * 4 + rq, rl = ai * 128 + wr * 64 + r;
                const f32x4 val = *(const LAS f32x4*)(stg + r * 256 + ((c ^ (r & 15)) << 4));
                const float rs = *(const LAS float*)(tab + rl * 4);
                *(f32x4*)(outy + (size_t)(u.pm * 256 + rl) * D + colL) = val * rs * gl;
            }
            asm volatile("s_waitcnt lgkmcnt(0)" ::: "memory");
        }
    }
};
template <int W> __device__ __forceinline__ void pool_lane(const float (&x)[8], float (&p)[8]) {
    float pre[8]; pre[0] = x[0];
#pragma unroll
    for (int i = 1; i < 8; ++i) pre[i] = pre[i - 1] + x[i];
    const float S = pre[7];
    float win[8];
    if (W == 2) {
        const float h = dpp_shr1(x[7]);
#pragma unroll
        for (int i = 0; i < 8; ++i) win[i] = x[i] + (i >= 1 ? x[i - 1] : h);
    } else if (W == 4) {
#pragma unroll
        for (int i = 0; i < 8; ++i) win[i] = i >= 4 ? pre[i] - pre[i - 4] : (i == 3 ? pre[3] : pre[i] + dpp_shr1(S - pre[i + 4]));
    } else if (W == 8) {
#pragma unroll
        for (int i = 0; i < 8; ++i) win[i] = i == 7 ? pre[7] : pre[i] + dpp_shr1(S - pre[i]);
    } else {
        const float s1 = dpp_shr1(S);
#pragma unroll
        for (int i = 0; i < 8; ++i) win[i] = i == 7 ? pre[7] + s1 : pre[i] + s1 + dpp_shr2(S - pre[i]);
    }
#pragma unroll
    for (int i = 0; i < 8; ++i) p[i] = win[i] * (1.0f / W) - x[i];
}
struct Epi3 {
    LAS unsigned char* rsb;
    bf16_t* Y1; float* HV; float* PV; bf16_t* PSZ; float* SV; bf16_t* SSZ;
    __device__ __forceinline__ void operator()(const f32x4 (&acc)[2][2][4][2], const Unit& u, int wr, int wc, int fr, int fq) const {
        const int e0 = u.pn * 128 + wc * 32 + fq * 8;
        const int t0 = u.pm * 256 + wr * 128 + fr * 8;
        float r[8];
        { const LAS f32x4* rp = (const LAS f32x4*)(rsb + (u.slot & 1) * 1024 + (wr * 128 + fr * 8) * 4); const f32x4 r0 = rp[0], r1 = rp[1];
#pragma unroll
          for (int i = 0; i < 4; ++i) { r[i] = r0[i]; r[4 + i] = r1[i]; } }
        u32x4 szp[8];
#pragma unroll
        for (int i = 0; i < 8; ++i) {
            const f32x4 z0 = acc[i >> 2][1][i & 3][0] * r[i], z1 = acc[i >> 2][1][i & 3][1] * r[i];
            float sz[8];
#pragma unroll
            for (int j = 0; j < 4; ++j) { sz[j] = z0[j] * sigm(z0[j]); sz[4 + j] = z1[j] * sigm(z1[j]); }
            szp[i] = f32_to_bf8(sz);
        }
        f32x4 ua[8], ub[8];
#pragma unroll
        for (int i = 0; i < 8; ++i) { ua[i] = acc[i >> 2][0][i & 3][0] * r[i]; ub[i] = acc[i >> 2][0][i & 3][1] * r[i]; }
        if (u.pm >= MP / 256) {
            const int s0 = t0 - MP;
#pragma unroll
            for (int i = 0; i < 8; ++i) { float* o = SV + (size_t)(s0 + i) * E + e0; *(f32x4*)o = ua[i]; *(f32x4*)(o + 4) = ub[i]; *(u32x4*)(SSZ + (size_t)(s0 + i) * E + e0) = szp[i]; }
            return;
        }
        const int run = 2 * u.pm + wr;
        if (fr < 2) {
#pragma unroll
            for (int i = 0; i < 8; ++i) { const size_t o = ((size_t)run * 16 + fr * 8 + i) * E + e0; *(f32x4*)(PV + o) = ua[i]; *(f32x4*)(PV + o + 4) = ub[i]; *(u32x4*)(PSZ + o) = szp[i]; }
        }
        if (fr >= 14) {
#pragma unroll
            for (int i = 0; i < 8; ++i) { const int idx = fr * 8 + i - (128 - PH);
                if (idx >= 0) { float* o = HV + ((size_t)run * PH + idx) * E + e0; *(f32x4*)o = ua[i]; *(f32x4*)(o + 4) = ub[i]; } }
        }
        float pp[8][8];
        const int grp = u.pn >> 2;
#pragma unroll
        for (int c = 0; c < 8; ++c) {
            float x[8], p[8];
#pragma unroll
            for (int i = 0; i < 8; ++i) x[i] = c < 4 ? ua[i][c & 3] : ub[i][c & 3];
            if (grp == 0) pool_lane<2>(x, p); else if (grp == 1) pool_lane<4>(x, p); else if (grp == 2) pool_lane<8>(x, p); else pool_lane<16>(x, p);
#pragma unroll
            for (int i = 0; i < 8; ++i) pp[i][c] = p[i];
        }
        const rsrc_t y1r = mk_rsrc(Y1, (unsigned)((size_t)M * E * 2));
        if (fr >= 2) {
#pragma unroll
            for (int i = 0; i < 8; ++i) { float f[8]; bf8_to_f32(szp[i], f);
#pragma unroll
                for (int c = 0; c < 8; ++c) f[c] *= pp[i][c];
                st16_wt(y1r, (unsigned)(((size_t)(t0 + i) * E + e0) * 2), f32_to_bf8(f)); }
        }
    }
};
struct EpiWp {
    bf16_t* W3T;
    __device__ __forceinline__ void operator()(const f32x4 (&acc)[2][2][4][2], const Unit& u, int wr, int wc, int fr, int fq) const {
#pragma unroll
        for (int ai = 0; ai < 2; ++ai)
#pragma unroll
            for (int m = 0; m < 4; ++m) {
                const int e = u.pm * 256 + ai * 128 + wr * 64 + (m >> 1) * 32 + (fr >> 2) * 8 + (m & 1) * 4 + (fr & 3);
                bf16_t* rowp = W3T + (size_t)dest_row(1, e) * D + u.pn * 256 + wc * 32 + fq * 4;
#pragma unroll
                for (int bj = 0; bj < 2; ++bj)
#pragma unroll
                    for (int n = 0; n < 2; ++n) { const f32x4 v = acc[ai][bj][m][n]; u32x2 w; w.x = cvt_pk_bf16(v[0], v[1]); w.y = cvt_pk_bf16(v[2], v[3]); *(u32x2*)(rowp + bj * 128 + n * 16) = w; }
            }
    }
};
template <bool GATHER> struct EpiU {
    const float* ssp1; float* out;
    __device__ __forceinline__ void operator()(const f32x4 (&acc)[2][2][4][2], const Unit& u, int wr, int wc, int fr, int fq) const {
        const int col0 = u.pn * 256 + wc * 32 + fq * 8;
#pragma unroll
        for (int ai = 0; ai < (GATHER ? 1 : 2); ++ai)
#pragma unroll
            for (int m = 0; m < 4; ++m) {
                int row; float* dst; bool ok = true;
                if (GATHER) { const int b = wr * 4 + m; row = b * SEQ + (SEQ - 16) + fr; ok = fr >= 1; dst = out + O_NPP + ((size_t)b * PH + (fr >= 1 ? fr - 1 : 0)) * E; }
                else { row = u.pm * 256 + ai * 128 + wr * 64 + m * 16 + fr; const int rsn = row - MP; dst = out + O_NPS + ((size_t)(rsn >> 2) * PH + (PH - DSEQ) + (rsn & 3)) * E; }
                const f32x4* sp = (const f32x4*)(ssp1 + (size_t)row * 16);
                const f32x4 st = (sp[0] + sp[1]) + (sp[2] + sp[3]);
                const float r = rsqrtf(((st[0] + st[1]) + (st[2] + st[3])) * (1.0f / D) + EPS);
                if (ok) {
#pragma unroll
                    for (int bj = 0; bj < 2; ++bj) { *(f32x4*)(dst + col0 + bj * 128) = acc[ai][bj][m][0] * r; *(f32x4*)(dst + col0 + bj * 128 + 4) = acc[ai][bj][m][1] * r; } }
            }
    }
};
struct EpiHist {
    float* HP;
    __device__ __forceinline__ void operator()(const f32x4 (&acc)[2][2][4][2], const Unit& u, int wr, int wc, int fr, int fq) const {
        const int col0 = u.pn * 256 + wc * 32 + fq * 8;
#pragma unroll
        for (int ai = 0; ai < 2; ++ai)
#pragma unroll
            for (int m = 0; m < 4; ++m) { float* rowp = HP + (size_t)(u.pm * 256 + ai * 128 + wr * 64 + m * 16 + fr) * E + col0;
#pragma unroll
                for (int bj = 0; bj < 2; ++bj) { *(f32x4*)(rowp + bj * 128) = acc[ai][bj][m][0]; *(f32x4*)(rowp + bj * 128 + 4) = acc[ai][bj][m][1]; } }
    }
};

#define XB_TMO      128
#define XB_XCNT(j)  (256  + 64 * (j))
#define XB_XSUB(j)  (1280 + 64 * (j))
#define XB_XGEN(j)  (2304 + 64 * (j))
#define XB_TOP      3328
#define XB_TOPGEN   3392
#define XCD_BAR_WORDS 3456
#define XB_SPIN_CAP (1u << 18)
__device__ __forceinline__ unsigned xb_ld(unsigned* p)              { return __hip_atomic_load(p, __ATOMIC_RELAXED, __HIP_MEMORY_SCOPE_AGENT); }
__device__ __forceinline__ unsigned xb_add(unsigned* p, unsigned v) { return __hip_atomic_fetch_add(p, v, __ATOMIC_RELAXED, __HIP_MEMORY_SCOPE_AGENT); }
__device__ __forceinline__ unsigned xb_xcc_id() { return (unsigned)__builtin_amdgcn_s_getreg((3 << 11) | 20) & 0xFu; }
#define XB_SPIN(cond, bar) do { unsigned _sp = 0; while (cond) { __builtin_amdgcn_s_sleep(1); \
    if ((++_sp & 255u) == 0u) { if (xb_ld(&(bar)[XB_TMO])) break; if (_sp > XB_SPIN_CAP) { atomicAdd(&(bar)[XB_TMO], 1u); break; } } } } while (0)
struct XcdBarrier { unsigned* bar; unsigned x; volatile LAS unsigned* st; };
__device__ __forceinline__ XcdBarrier xcd_barrier_post(unsigned* bar, volatile LAS unsigned* st) {
    XcdBarrier b; b.bar = bar; b.x = xb_xcc_id(); b.st = st;
    if (threadIdx.x == 0) (void)xb_add(&bar[XB_XCNT(b.x)], 1u);
    return b;
}
__device__ __forceinline__ void xcd_barrier_complete(unsigned* bar, unsigned x, unsigned& nloc, unsigned& nx) {
    const unsigned G = gridDim.x * gridDim.y * gridDim.z;
    unsigned sum, cnt, mine, sp = 0u;
    for (;;) {
        sum = 0u; cnt = 0u; mine = 0u;
#pragma unroll
        for (unsigned j = 0; j < 16; ++j) { const unsigned c = xb_ld(&bar[XB_XCNT(j)]); sum += c; cnt += (c > 0u) ? 1u : 0u; mine = (j == x) ? c : mine; }
        if (sum == G) break;
        __builtin_amdgcn_s_sleep(1);
        if ((++sp & 255u) == 0u) { if (xb_ld(&bar[XB_TMO])) break; if (sp > XB_SPIN_CAP) { atomicAdd(&bar[XB_TMO], 1u); break; } }
    }
    nloc = mine > 0u ? mine : 1u; nx = cnt > 0u ? cnt : 1u;
}
__device__ __forceinline__ void xcd_barrier(const XcdBarrier& b) {
    asm volatile("s_waitcnt vmcnt(0)" ::: "memory");
    __syncthreads();
    if (threadIdx.x == 0) {
        unsigned* bar = b.bar;
        __builtin_amdgcn_s_waitcnt(0);
        unsigned nloc = b.st[0], nx = b.st[1];
        if (nloc == 0u) { xcd_barrier_complete(bar, b.x, nloc, nx); b.st[0] = nloc; b.st[1] = nx; }
        const unsigned old = xb_add(&bar[XB_XSUB(b.x)], 1u);
        const unsigned gen = old / nloc;
        if (old + 1u == (gen + 1u) * nloc) {
            __builtin_amdgcn_fence(__ATOMIC_RELEASE, "agent");
            asm volatile("s_waitcnt vmcnt(0)" ::: "memory");
            const unsigned og = xb_add(&bar[XB_TOP], 1u);
            const unsigned tg = og / nx;
            if (og + 1u == (tg + 1u) * nx) xb_add(&bar[XB_TOPGEN], 1u);
            else XB_SPIN(xb_ld(&bar[XB_TOPGEN]) == tg, bar);
            __builtin_amdgcn_fence(__ATOMIC_ACQUIRE, "agent");
            xb_add(&bar[XB_XGEN(b.x)], 1u);
            asm volatile("s_waitcnt vmcnt(0)" ::: "memory");
        } else {
            XB_SPIN(xb_ld(&bar[XB_XGEN(b.x)]) == gen, bar);
            __builtin_amdgcn_fence(__ATOMIC_ACQUIRE, "agent");
            asm volatile("s_waitcnt vmcnt(0)" ::: "memory");
        }
    }
    __syncthreads();
}

__device__ __forceinline__ void p0_item_load(const float* W, int N, int item, int lane, float (&wv)[32]) {
    const int nblk = N / 32, kb = item / nblk, nb = item % nblk, k0 = 64 * kb, n0 = 32 * nb;
#pragma unroll
    for (int i = 0; i < 32; ++i) wv[i] = __builtin_nontemporal_load(W + (size_t)(k0 + 2 * i + (lane >> 5)) * N + n0 + (lane & 31));
}
template <bool WTHRU = false> __device__ __forceinline__ void p0_item_finish(float (&wv)[32], int K, int N, const float* gk, bf16_t* WT, int row_off, int kind, LAS float* scr, int item, int lane) {
    const int nblk = N / 32, kb = item / nblk, nb = item % nblk, k0 = 64 * kb, n0 = 32 * nb;
    if (gk) {
#pragma unroll
        for (int i = 0; i < 32; ++i) wv[i] *= gk[k0 + 2 * i + (lane >> 5)]; }
#pragma unroll
    for (int i = 0; i < 32; ++i) scr[(2 * i + (lane >> 5)) * 33 + (lane & 31)] = wv[i];
    LDS_WAIT(); asm volatile("" ::: "memory");
    const int c = lane & 7;
#pragma unroll
    for (int j = 0; j < 4; ++j) { const int n = (lane >> 3) + 8 * j; const LAS float* s = scr + (8 * c) * 33 + n;
        u32x4 o; o.x = cvt_pk_bf16(s[0 * 33], s[1 * 33]); o.y = cvt_pk_bf16(s[2 * 33], s[3 * 33]); o.z = cvt_pk_bf16(s[4 * 33], s[5 * 33]); o.w = cvt_pk_bf16(s[6 * 33], s[7 * 33]);
        if constexpr (WTHRU) st16_wt(mk_rsrc(WT, 0x7fffffffu), (unsigned)(((size_t)(row_off + dest_row(kind, n0 + n)) * K + k0 + 8 * c) * 2), o);
        else *(u32x4*)(WT + (size_t)(row_off + dest_row(kind, n0 + n)) * K + k0 + 8 * c) = o; }
    LDS_WAIT(); asm volatile("" ::: "memory");
}
template <bool WTHRU = false> __device__ __forceinline__ void p0_transpose_item(const float* W, int K, int N, const float* gk, bf16_t* WT, int row_off, int kind, LAS float* scr, int item, int lane) {
    float wv[32]; p0_item_load(W, N, item, lane, wv); p0_item_finish<WTHRU>(wv, K, N, gk, WT, row_off, kind, scr, item, lane);
}

struct SchedG1 : pg8::StaticOrder {
    const float* rs0; const float* conv_w; const float* conv_b; LAS unsigned char* tab;
    __device__ __forceinline__ void a_ready(const Unit& u) const {
        const int lane = threadIdx.x & 63, wave = __builtin_amdgcn_readfirstlane(threadIdx.x >> 6);
        LAS unsigned char* t = tab + (u.slot & 1) * 2048;
        if (wave == 0) __builtin_amdgcn_global_load_lds((const unsigned*)(rs0 + (size_t)u.pm * 256 + lane * 4), (LAS unsigned*)t, 16, 0, 0);
        else if (wave == 1) { const int a = lane >> 4, c4 = (lane & 15) * 4;
            const float* src = (a < 3 ? conv_w + (size_t)a * E : conv_b) + u.pn * 64 + c4;
            __builtin_amdgcn_global_load_lds((const unsigned*)src, (LAS unsigned*)(t + 1024), 16, 0, 0); }
    }
};
struct SchedG2 {
    int c; unsigned* cnt2;
    __device__ __forceinline__ bool next(int i, Unit& u) const { u.slot = i & 1; if (i == 0) { prompt_unit(c, 4, u); return true; } if (i == 1 && c < 8) { u.pm = 64 + (c >> 2); u.pn = c & 3; return true; } return false; }
    __device__ __forceinline__ void a_ready(const Unit&) const {}
    __device__ __forceinline__ void done(const Unit& u, int) const {
        asm volatile("s_waitcnt vmcnt(0)" ::: "memory"); __builtin_amdgcn_s_barrier();
        if (threadIdx.x == 0) __hip_atomic_fetch_add(cnt2 + 64 * u.pm, 1u, __ATOMIC_RELAXED, __HIP_MEMORY_SCOPE_AGENT); }
};
struct SchedG3 {
    int c; const unsigned* cnt2; const float* ss1; LAS unsigned char* rsb;
    __device__ __forceinline__ bool next(int i, Unit& u) const {
        if (c >= 8) {
            if (i < 4) { u.pm = 8 * (c & 7) + ((c >> 3) & 7); u.pn = 4 * (c >> 6) + i; u.slot = i ? 2 : 0; return true; }
            if (i == 4 && c - 8 < 48) { const int k = c - 8; if (k < 16) { u.pm = 8 * (k & 7); u.pn = 2 + (k >> 3); } else { u.pm = 64 + ((k - 16) >> 4); u.pn = (k - 16) & 15; } u.slot = 1; return true; }
            return false;
        }
        if (i < 2) { u.pm = 8 * c; u.pn = i; u.slot = i ? 2 : 0; return true; }
        return false;
    }
    __device__ __forceinline__ void a_ready(const Unit& u) const {
        if (u.slot & 2) return;
        wait_count(cnt2 + 64 * u.pm, 4u);
        const int t = threadIdx.x;
        if (t < 256) { const f32x4* sp = (const f32x4*)(ss1 + ((size_t)u.pm * 256 + t) * 16);
            const f32x4 st = (sp[0] + sp[1]) + (sp[2] + sp[3]);
            *(LAS float*)(rsb + (u.slot & 1) * 1024 + t * 4) = rsqrtf(((st[0] + st[1]) + (st[2] + st[3])) * (1.0f / D) + EPS); }
    }
    __device__ __forceinline__ void done(const Unit&, int) const {}
};
struct SchedOne {
    int pm, pn; bool has;
    __device__ __forceinline__ bool next(int i, Unit& u) const { u.slot = 0; if (has && i == 0) { u.pm = pm; u.pn = pn; return true; } return false; }
    __device__ __forceinline__ void a_ready(const Unit&) const {}
    __device__ __forceinline__ void done(const Unit&, int) const {}
};
struct SchedG5 {
    int c;
    __device__ __forceinline__ bool next(int i, Unit& u) const { u.slot = 0; if (i == 0) { prompt_unit(c, 4, u); return true; } return false; }
    __device__ __forceinline__ void a_ready(const Unit&) const {}
    __device__ __forceinline__ void done(const Unit&, int) const {}
};

template <int W, int NT> __device__ __forceinline__ void pool_slide(const float* hist, bool zero_hist, const float* cur, const bf16_t* sz, bf16_t* y1) {
    f32x4 x[W - 1 + NT]; u32x2 zw[NT];
#pragma unroll
    for (int i = 0; i < W - 1; ++i) x[i] = zero_hist ? (f32x4){0.f, 0.f, 0.f, 0.f} : *(const f32x4*)(hist + (size_t)(PH - (W - 1) + i) * E);
#pragma unroll
    for (int t = 0; t < NT; ++t) { x[W - 1 + t] = *(const f32x4*)(cur + (size_t)t * E); zw[t] = *(const u32x2*)(sz + (size_t)t * E); }
    f32x4 s = (f32x4){0.f, 0.f, 0.f, 0.f};
#pragma unroll
    for (int i = 0; i < W - 1; ++i) s += x[i];
#pragma unroll
    for (int t = 0; t < NT; ++t) {
        s += x[W - 1 + t];
        const float inv = 1.0f / (float)((zero_hist && t + 1 < W) ? t + 1 : W);
        const f32x4 c = x[W - 1 + t];
        u32x2 o; o.x = cvt_pk_bf16((s[0] * inv - c[0]) * bflo(zw[t].x), (s[1] * inv - c[1]) * bfhi(zw[t].x)); o.y = cvt_pk_bf16((s[2] * inv - c[2]) * bflo(zw[t].y), (s[3] * inv - c[3]) * bfhi(zw[t].y));
        *(u32x2*)(y1 + (size_t)t * E) = o;
        s -= x[t];
    }
}
template <int W> __device__ __forceinline__ void pool_slide_smp(const float* hist, const float* cur, const bf16_t* sz, rsrc_t y1r, unsigned y1off) {
    f32x4 xa[W - 1 + DSEQ], xb[W - 1 + DSEQ]; u32x4 zw[DSEQ];
#pragma unroll
    for (int i = 0; i < W - 1; ++i) { const float* hp = hist + (size_t)(PH - (W - 1) + i) * E; xa[i] = *(const f32x4*)hp; xb[i] = *(const f32x4*)(hp + 4); }
#pragma unroll
    for (int t = 0; t < DSEQ; ++t) { xa[W - 1 + t] = *(const f32x4*)(cur + (size_t)t * E); xb[W - 1 + t] = *(const f32x4*)(cur + (size_t)t * E + 4); zw[t] = *(const u32x4*)(sz + (size_t)t * E); }
    f32x4 sa = (f32x4){0.f, 0.f, 0.f, 0.f}, sb = (f32x4){0.f, 0.f, 0.f, 0.f};
#pragma unroll
    for (int i = 0; i < W - 1; ++i) { sa += xa[i]; sb += xb[i]; }
    constexpr float inv = 1.0f / (float)W;
#pragma unroll
    for (int t = 0; t < DSEQ; ++t) {
        sa += xa[W - 1 + t]; sb += xb[W - 1 + t];
        const f32x4 ca = xa[W - 1 + t], cb = xb[W - 1 + t];
        u32x4 o;
        o.x = cvt_pk_bf16((sa[0] * inv - ca[0]) * bflo(zw[t].x), (sa[1] * inv - ca[1]) * bfhi(zw[t].x)); o.y = cvt_pk_bf16((sa[2] * inv - ca[2]) * bflo(zw[t].y), (sa[3] * inv - ca[3]) * bfhi(zw[t].y));
        o.z = cvt_pk_bf16((sb[0] * inv - cb[0]) * bflo(zw[t].z), (sb[1] * inv - cb[1]) * bfhi(zw[t].z)); o.w = cvt_pk_bf16((sb[2] * inv - cb[2]) * bflo(zw[t].w), (sb[3] * inv - cb[3]) * bfhi(zw[t].w));
        st16_wt(y1r, y1off + (unsigned)(t * E * 2), o);
        sa -= xa[t]; sb -= xb[t];
    }
}
template <int W> __device__ __forceinline__ void pool_fix_run(int r, int e, const float* HV, const float* PV, const bf16_t* PSZ, bf16_t* Y1) {
    const bool first = (r & 15) == 0;
    pool_slide<W, 16>(HV + ((size_t)(first ? r : r - 1) * PH) * E + e, first, PV + ((size_t)r * 16) * E + e, PSZ + ((size_t)r * 16) * E + e, Y1 + ((size_t)r * 128) * E + e);
}

struct Args { const float* in[14]; float* out; unsigned char* ws; };

__global__ void __launch_bounds__(512, 2) fwd_kernel(Args a) {
    extern __shared__ __attribute__((aligned(16))) unsigned char lds_raw[];
    LAS unsigned char* lds = (LAS unsigned char*)lds_raw;
    const int G = gridDim.x, bx = blockIdx.x;
    const int vcu = (G % 8 == 0) ? (bx % 8) * (G / 8) + bx / 8 : bx;
#define PHASE_IDS() int tid = threadIdx.x; asm volatile("" : "+v"(tid)); const int lane = tid & 63, wave = __builtin_amdgcn_readfirstlane(tid >> 6); \
    const int gw = vcu * 8 + wave, NGW = G * 8, gtid = vcu * 512 + tid, NGT = G * 512; (void)lane; (void)gw; (void)NGW; (void)gtid; (void)NGT
    const float* x_p = a.in[0]; const float* x_s = a.in[1]; const float* st_conv = a.in[2]; const float* st_pool = a.in[3];
    const float* norm_g = a.in[4]; const float* fin_g = a.in[5]; const float* w_in1 = a.in[6]; const float* conv_w = a.in[7]; const float* conv_b = a.in[8];
    const float* w_out1 = a.in[9]; const float* w_in2 = a.in[10]; const float* w_grp = a.in[11]; const float* p_scale = a.in[12]; const float* w_out2 = a.in[13];
    float* out = a.out; unsigned char* ws = a.ws;
    bf16_t* W1T = (bf16_t*)(ws + WS_W1T); bf16_t* W2T = (bf16_t*)(ws + WS_W2T); bf16_t* W3T = (bf16_t*)(ws + WS_W3T); bf16_t* W4T = (bf16_t*)(ws + WS_W4T); bf16_t* W5T = (bf16_t*)(ws + WS_W5T);
    bf16_t* WUB = (bf16_t*)(ws + WS_WUB); bf16_t* W3U = (bf16_t*)(ws + WS_W3U); bf16_t* SPB = (bf16_t*)(ws + WS_SPB);
    bf16_t* XB = (bf16_t*)(ws + WS_XB); bf16_t* BB = (bf16_t*)(ws + WS_B);
    float* HCV = (float*)(ws + WS_HCV); float* PGB = (float*)(ws + WS_PGB); float* PCV = (float*)(ws + WS_PCV);
    float* HV = (float*)(ws + WS_HV); float* PV = (float*)(ws + WS_PV); bf16_t* PSZ = (bf16_t*)(ws + WS_PSZ); float* SV = (float*)(ws + WS_SV); bf16_t* SSZ = (bf16_t*)(ws + WS_SSZ);
    float* HP = (float*)(ws + WS_HP); float* SLAB = (float*)(ws + WS_SLAB);
    float* rs0 = (float*)(ws + WS_RS0); float* ss1 = (float*)(ws + WS_SS1);
    volatile LAS unsigned* bst = (volatile LAS unsigned*)(lds + 131072 + 64);
    if (threadIdx.x < 2) bst[threadIdx.x] = 0u;
    __syncthreads();
    const XcdBarrier xbar = xcd_barrier_post((unsigned*)(ws + WS_CTL), bst);
#define GRID_SYNC() xcd_barrier(xbar)
    unsigned* cnt2 = (unsigned*)(ws + WS_CTL) + 4096; unsigned* cnt5 = cnt2 + 64 * 128;
#define CVT_HALF_ROW(src, dst, sc) do { f32x4 _v[4]; _Pragma("unroll") for (int _j = 0; _j < 4; ++_j) _v[_j] = __builtin_nontemporal_load((const f32x4*)((src) + (64 * _j + lane) * 4)); \
        _Pragma("unroll") for (int _j = 0; _j < 4; ++_j) { u32x2 _w; _w.x = cvt_pk_bf16(_v[_j][0] * (sc), _v[_j][1] * (sc)); _w.y = cvt_pk_bf16(_v[_j][2] * (sc), _v[_j][3] * (sc)); *(u32x2*)((dst) + (64 * _j + lane) * 4) = _w; } } while (0)

    {
        PHASE_IDS();
        LAS float* scr = (LAS float*)(lds + wave * 16384);
        constexpr int I1 = (D / 64) * (N1 / 32);
        static_assert(I1 == 2 * 256 * 8, "two weight items per wave on a 256-workgroup grid");
        float wa[32], wb[32];
        p0_item_load(w_in1, N1, gw, lane, wa); p0_item_load(w_in1, N1, gw + NGW, lane, wb);
        int row0 = gw * 2;
        f32x4 v[2][4], vn[2][4];
        { const float* xr = row0 < MP ? x_p + (size_t)row0 * D : x_s + (size_t)(row0 - MP) * D;
#pragma unroll
          for (int q = 0; q < 2; ++q)
#pragma unroll
            for (int j = 0; j < 4; ++j) v[q][j] = __builtin_nontemporal_load((const f32x4*)(xr + (size_t)q * D + (64 * j + lane) * 4)); }
        p0_item_finish(wa, D, N1, norm_g, W1T, 0, 0, scr, gw, lane);
        p0_item_finish(wb, D, N1, norm_g, W1T, 0, 0, scr, gw + NGW, lane);
        for (; row0 < M; row0 += NGW * 2) {
            const int rn = row0 + NGW * 2;
            if (rn < M) { const float* xr = rn < MP ? x_p + (size_t)rn * D : x_s + (size_t)(rn - MP) * D;
#pragma unroll
                for (int q = 0; q < 2; ++q)
#pragma unroll
                    for (int j = 0; j < 4; ++j) vn[q][j] = __builtin_nontemporal_load((const f32x4*)(xr + (size_t)q * D + (64 * j + lane) * 4)); }
            float ss[2];
#pragma unroll
            for (int q = 0; q < 2; ++q) { float a = 0.f;
#pragma unroll
                for (int j = 0; j < 4; ++j) a += (v[q][j][0] * v[q][j][0] + v[q][j][1] * v[q][j][1]) + (v[q][j][2] * v[q][j][2] + v[q][j][3] * v[q][j][3]);
                ss[q] = wave_sum(a); }
#pragma unroll
            for (int q = 0; q < 2; ++q)
#pragma unroll
                for (int j = 0; j < 4; ++j) { u32x2 w; w.x = cvt_pk_bf16(v[q][j][0], v[q][j][1]); w.y = cvt_pk_bf16(v[q][j][2], v[q][j][3]); *(u32x2*)(XB + (size_t)(row0 + q) * D + (64 * j + lane) * 4) = w; }
            if (lane < 2) rs0[row0 + lane] = rsqrtf((lane == 0 ? ss[0] : ss[1]) * (1.0f / D) + EPS);
#pragma unroll
            for (int q = 0; q < 2; ++q)
#pragma unroll
                for (int j = 0; j < 4; ++j) v[q][j] = vn[q][j];
        }
    }
    GRID_SYNC();

    {
        pg8::Gemm g{XB, W1T, M, N1, D, D, 0, 0, D, 0, 0}; SchedG1 S; S.init(M, N1, G, bx); S.rs0 = rs0; S.conv_w = conv_w; S.conv_b = conv_b; S.tab = lds + pg8::STAGE_BYTES + 1024;
        Epi1 Ep{lds + pg8::STAGE_BYTES + 1024, BB, HCV, PGB, PCV, st_conv, out};
        pg8::gemm_phase<Epi1, SchedG1, true, true, 1>(lds, g, S, Ep);
    }
    unsigned* cntW = cnt5 + 64 * 80;
    if (bx >= 64 && bx < 96) {
        const int idx = bx - 64;
        wait_count(cntW, (unsigned)(G - 96));
        pg8::Gemm g{W4T, WUB, E, D, GC, GC, 0, 0, E, 1, GC}; SchedOne S{idx >> 2, idx & 3, true};
        EpiWp Ep{W3T};
        pg8::gemm_phase<EpiWp, SchedOne, true, true, 0>(lds, g, S, Ep);
    } else if (bx >= 96) {
        PHASE_IDS();
        LAS float* scr = (LAS float*)(lds + wave * 16384);
        constexpr int IT = (D / 64) * (E / 32);
        const int tw = (bx - 96) * 8 + wave, NTW = (G - 96) * 8;
        { constexpr int I4 = (GC / 64) * (GC / 32);
          for (int it = tw; it < 4 * I4; it += NTW) { const int g = it / I4; p0_transpose_item<true>(w_grp + (size_t)g * GC * GC, GC, GC, nullptr, W4T, g * GC, 2, scr, it % I4, lane); }
          const rsrc_t ur = mk_rsrc(WUB, (unsigned)((size_t)D * E * 2));
          for (int it = tw; it < D * 2; it += NTW) { const int k = it >> 1, hf = it & 1; const float sc = norm_g[D + k]; const float* src = w_in2 + (size_t)k * N3 + hf * 1024;
              f32x4 va[2], vb[2];
#pragma unroll
              for (int j = 0; j < 2; ++j) { va[j] = __builtin_nontemporal_load((const f32x4*)(src + (64 * j + lane) * 8)); vb[j] = __builtin_nontemporal_load((const f32x4*)(src + (64 * j + lane) * 8 + 4)); }
#pragma unroll
              for (int j = 0; j < 2; ++j) { u32x4 o; o.x = cvt_pk_bf16(va[j][0] * sc, va[j][1] * sc); o.y = cvt_pk_bf16(va[j][2] * sc, va[j][3] * sc); o.z = cvt_pk_bf16(vb[j][0] * sc, vb[j][1] * sc); o.w = cvt_pk_bf16(vb[j][2] * sc, vb[j][3] * sc);
                  st16_wt(ur, (unsigned)(((size_t)k * E + hf * 1024 + (64 * j + lane) * 8) * 2), o); } }
          asm volatile("s_waitcnt vmcnt(0)" ::: "memory"); __syncthreads();
          if (tid == 0) __hip_atomic_fetch_add(cntW, 1u, __ATOMIC_RELAXED, __HIP_MEMORY_SCOPE_AGENT); }
        for (int it = tw; it < 3 * IT; it += NTW) {
            const int r = it & (IT - 1), kb = r >> 6, nb = r & 63;
            if (it < IT) p0_transpose_item(w_out1, E, D, nullptr, W2T, 0, 2, scr, r, lane);
            else if (it < 2 * IT) p0_transpose_item(w_in2, D, N3, norm_g + D, W3T, 0, 1, scr, kb * (N3 / 32) + 64 + nb, lane);
            else p0_transpose_item(w_in2, D, N3, norm_g + D, W3U, 0, 2, scr, kb * (N3 / 32) + nb, lane);
        }
        for (int it = tw; it < 2048 * 2; it += NTW) {
            const int row = it >> 1, hf = it & 1;
            if (row < DB * PH) CVT_HALF_ROW(st_pool + (size_t)row * E + hf * 1024, SPB + (size_t)row * E + hf * 1024, 1.0f);
            else {
#pragma unroll
                for (int j = 0; j < 4; ++j) *(u32x2*)(SPB + (size_t)row * E + hf * 1024 + (64 * j + lane) * 4) = (u32x2){0u, 0u}; }
        }
    }
    GRID_SYNC();
    {
        PHASE_IDS(); (void)gw;
        Unit u; prompt_unit(bx, 4, u);
        const int c = tid & 255, e = c * 8, run = 2 * u.pm + (tid >> 8);
        float w0[8], w1[8], w2[8], bb[8];
#pragma unroll
        for (int j = 0; j < 8; ++j) { w0[j] = conv_w[e + j]; w1[j] = conv_w[E + e + j]; w2[j] = conv_w[2 * E + e + j]; bb[j] = conv_b[e + j]; }
        float h0[8], h1[8], g0[8], g1[8], c0[8], c1[8];
        if (run & 15) { const float* h = HCV + ((size_t)(run - 1) * 2) * E + e;
#pragma unroll
            for (int j = 0; j < 8; ++j) { h0[j] = h[j]; h1[j] = h[E + j]; } }
        else {
#pragma unroll
            for (int j = 0; j < 8; ++j) { h0[j] = 0.f; h1[j] = 0.f; } }
        const float* pg = PGB + ((size_t)run * 2) * E + e; const float* pc = PCV + ((size_t)run * 2) * E + e;
#pragma unroll
        for (int j = 0; j < 8; ++j) { g0[j] = pg[j]; g1[j] = pg[E + j]; c0[j] = pc[j]; c1[j] = pc[E + j]; }
        float y0[8], y1[8];
#pragma unroll
        for (int j = 0; j < 8; ++j) { y0[j] = g0[j] * (bb[j] + w0[j] * h0[j] + w1[j] * h1[j] + w2[j] * c0[j]); y1[j] = g1[j] * (bb[j] + w0[j] * h1[j] + w1[j] * c0[j] + w2[j] * c1[j]); }
        *(u32x4*)(BB + ((size_t)run * 128) * E + e) = f32_to_bf8(y0); *(u32x4*)(BB + ((size_t)run * 128 + 1) * E + e) = f32_to_bf8(y1);
        asm volatile("s_waitcnt vmcnt(0)" ::: "memory"); __syncthreads();
    }
    {
        pg8::Gemm g{BB, W2T, M, D, E, E, 0, 0, E, 0, 0}; SchedG2 S{bx, cnt2};
        EpiRes<true> Ep{XB, ss1};
        pg8::gemm_phase<EpiRes<true>, SchedG2, true, true, 0>(lds, g, S, Ep);
    }
    {
        pg8::Gemm g{XB, W3T, M, N3, D, D, 0, 0, D, 0, 0}; SchedG3 S{bx, cnt2, ss1, lds + pg8::STAGE_BYTES + 1024};
        Epi3 Ep{lds + pg8::STAGE_BYTES + 1024, BB, HV, PV, PSZ, SV, SSZ};
        pg8::gemm_phase<Epi3, SchedG3, true, true, 1>(lds, g, S, Ep);
    }
    if (bx >= 64 && bx < 128) {
        const int idx = bx - 64;
        pg8::Gemm g{SPB, W4T, 2048, E, GC, E, 1, GC, GC, 0, 0}; SchedOne S{idx >> 3, idx & 7, true};
        EpiHist Ep{HP};
        pg8::gemm_phase<EpiHist, SchedOne, true, true, 0>(lds, g, S, Ep);
    } else if (bx >= 128 && bx < 144) {
        const int idx = bx - 128, pm = 64 + (idx >> 3);
        wait_count(cnt2 + 64 * pm, 4u);
        pg8::Gemm g{XB, W3U, M, E, D, D, 0, 0, D, 0, 0}; SchedOne S{pm, idx & 7, true};
        EpiU<false> Ep{ss1, out};
        pg8::gemm_phase<EpiU<false>, SchedOne, true, true, 0>(lds, g, S, Ep);
    } else if (bx < 8) {
        if (threadIdx.x < 64) { const int t = threadIdx.x; unsigned sp = 0;
            for (;;) { const bool rdy = t >= NB || __hip_atomic_load(cnt2 + 64 * (8 * (t < NB ? t : 0) + 7), __ATOMIC_RELAXED, __HIP_MEMORY_SCOPE_AGENT) >= 4u;
                if (__all(rdy)) break; __builtin_amdgcn_s_sleep(2); if (++sp > (1u << 21)) break; }
            __builtin_amdgcn_fence(__ATOMIC_ACQUIRE, "agent"); asm volatile("s_waitcnt vmcnt(0)" ::: "memory"); }
        __syncthreads();
        pg8::Gemm g{XB, W3U, M, E, D, D, 0, 0, D, 0, 0}; SchedOne S{0, bx, true};
        EpiU<true> Ep{ss1, out};
        pg8::gemm_phase<EpiU<true>, SchedOne, true, true, 2>(lds, g, S, Ep);
    } else if (bx >= 152) {
        { PHASE_IDS(); LAS float* scr = (LAS float*)(lds + wave * 16384);
          for (int it = (bx - 152) * 8 + wave; it < (E / 64) * (D / 32); it += (G - 152) * 8) p0_transpose_item(w_out2, E, D, p_scale, W5T, 0, 2, scr, it, lane); }
        const int tt = (bx - 152) * 512 + threadIdx.x, NTT = (G - 152) * 512;
        for (int i = tt; i < DB * (PH - DSEQ) * (E / 4); i += NTT) {
            const int b = i / ((PH - DSEQ) * (E / 4)), rem = i % ((PH - DSEQ) * (E / 4)), r = rem / (E / 4), c4 = rem % (E / 4);
            *(f32x4*)(out + O_NPS + ((size_t)b * PH + r) * E + c4 * 4) = *(const f32x4*)(st_pool + ((size_t)b * PH + DSEQ + r) * E + c4 * 4);
        }
    }
    GRID_SYNC();
    unsigned* cntS = cnt5 + 64 * 70;
    { PHASE_IDS(); (void)gw;
        Unit u; prompt_unit(bx, 4, u);
        if (tid < 128) { const int item = bx * 128 + tid, b = item >> 8, c8 = item & 255, es = c8 * 8, ws2 = c8 >> 6;
            const float* hp = HP + ((size_t)b * PH) * E + es; const float* cp = SV + ((size_t)b * DSEQ) * E + es; const bf16_t* zp = SSZ + ((size_t)b * DSEQ) * E + es;
            const rsrc_t yr = mk_rsrc(BB + (size_t)MP * E, (unsigned)((size_t)MS * E * 2)); const unsigned yo = (unsigned)((((size_t)b * DSEQ) * E + es) * 2);
            if (ws2 == 0) pool_slide_smp<2>(hp, cp, zp, yr, yo); else if (ws2 == 1) pool_slide_smp<4>(hp, cp, zp, yr, yo);
            else if (ws2 == 2) pool_slide_smp<8>(hp, cp, zp, yr, yo); else pool_slide_smp<16>(hp, cp, zp, yr, yo);
            count_in(cntS + 64 * (bx >> 5), lane); }
        const int e = tid * 4, wsh = wave >> 1;
#pragma unroll 1
        for (int j = 0; j < 2; ++j) { const int r = 2 * u.pm + j;
            if (wsh == 0) pool_fix_run<2>(r, e, HV, PV, PSZ, BB); else if (wsh == 1) pool_fix_run<4>(r, e, HV, PV, PSZ, BB);
            else if (wsh == 2) pool_fix_run<8>(r, e, HV, PV, PSZ, BB); else pool_fix_run<16>(r, e, HV, PV, PSZ, BB); }
        asm volatile("s_waitcnt vmcnt(0)" ::: "memory"); __syncthreads();
    }
    { PHASE_IDS(); (void)gw;
        wait_count(cntS + 64 * (bx >> 5), 64u);
        const int tn = (bx & 7) + 8 * ((bx >> 3) & 3), tm = bx >> 5, fr = lane & 15, fq = lane >> 4;
        const bf16_t* Ap = BB + (size_t)(MP + 64 * tm + fr) * E + 256 * wave + 8 * fq;
        const bf16_t* Bp[2] = {W5T + (size_t)dest_row(2, 32 * tn + fr) * E + 256 * wave + 8 * fq, W5T + (size_t)dest_row(2, 32 * tn + 16 + fr) * E + 256 * wave + 8 * fq};
        f32x4 acc[4][2];
#pragma unroll
        for (int m = 0; m < 4; ++m) { acc[m][0] = (f32x4){0.f, 0.f, 0.f, 0.f}; acc[m][1] = (f32x4){0.f, 0.f, 0.f, 0.f}; }
#pragma unroll
        for (int hf = 0; hf < 2; ++hf) {
            bf16x8 af[4][4], bfr[2][4];
#pragma unroll
            for (int kk = 0; kk < 4; ++kk) {
#pragma unroll
                for (int m = 0; m < 4; ++m) af[m][kk] = *(const bf16x8*)(Ap + (size_t)(16 * m) * E + 32 * (4 * hf + kk));
#pragma unroll
                for (int n = 0; n < 2; ++n) bfr[n][kk] = *(const bf16x8*)(Bp[n] + 32 * (4 * hf + kk));
            }
#pragma unroll
            for (int kk = 0; kk < 4; ++kk)
#pragma unroll
                for (int m = 0; m < 4; ++m)
#pragma unroll
                    for (int n = 0; n < 2; ++n) acc[m][n] = __builtin_amdgcn_mfma_f32_16x16x32_bf16(bfr[n][kk], af[m][kk], acc[m][n], 0, 0, 0);
        }
        LAS f32x4* red = (LAS f32x4*)lds;
#pragma unroll
        for (int m = 0; m < 4; ++m)
#pragma unroll
            for (int n = 0; n < 2; ++n) red[(wave * 8 + m * 2 + n) * 64 + lane] = acc[m][n];
        __syncthreads();
        f32x4 sm = red[wave * 64 + lane];
#pragma unroll
        for (int w = 1; w < 8; ++w) sm += red[(w * 8 + wave) * 64 + lane];
        const int rs = 64 * tm + 16 * (wave >> 1) + fr, col = 32 * tn + 16 * (wave & 1) + 4 * fq;
        const u32x2 xw = *(const u32x2*)(XB + (size_t)(MP + rs) * D + col);
        sm[0] += bflo(xw.x); sm[1] += bfhi(xw.x); sm[2] += bflo(xw.y); sm[3] += bfhi(xw.y);
        st16_wt(mk_rsrc(SLAB, (unsigned)((size_t)MS * D * 4)), (unsigned)(((size_t)rs * D + col) * 4), __builtin_bit_cast(u32x4, sm));
        asm volatile("s_waitcnt vmcnt(0)" ::: "memory"); __syncthreads();
        if (tid == 0) __hip_atomic_fetch_add(cnt5 + 64 * (64 + (tm >> 2)), 1u, __ATOMIC_RELAXED, __HIP_MEMORY_SCOPE_AGENT);
    }
    {
        pg8::Gemm g{BB, W5T, M, D, E, E, 0, 0, E, 0, 0}; SchedG5 S{bx};
        EpiG5 Ep{XB, ss1, cnt5, fin_g, out + O_Y, lds + pg8::STAGE_BYTES + 4096, lds};
        pg8::gemm_phase<EpiG5, SchedG5, true, true, 0>(lds, g, S, Ep);
    }
    if (bx >= 64 && bx < 128) { PHASE_IDS(); (void)gw;
        const int idx = bx - 64, pm = 64 + (idx >> 5);
        wait_count(cnt5 + 64 * pm, 128u);
        const int row = MP + idx * 8 + wave;
        f32x4 ga[2], gb[2];
#pragma unroll
        for (int j = 0; j < 2; ++j) { ga[j] = *(const f32x4*)(fin_g + (64 * j + lane) * 8); gb[j] = *(const f32x4*)(fin_g + (64 * j + lane) * 8 + 4); }
        float v[2][8]; float a = 0.f;
#pragma unroll
        for (int j = 0; j < 2; ++j) { const float* sp = SLAB + (size_t)(row - MP) * D + (64 * j + lane) * 8;
            const f32x4 s0 = *(const f32x4*)sp, s1 = *(const f32x4*)(sp + 4);
#pragma unroll
            for (int e = 0; e < 4; ++e) { v[j][e] = s0[e]; v[j][4 + e] = s1[e]; }
#pragma unroll
            for (int e = 0; e < 8; ++e) a += v[j][e] * v[j][e]; }
        const float r = rsqrtf(wave_sum(a) * (1.0f / D) + EPS);
#pragma unroll
        for (int j = 0; j < 2; ++j) {
            const f32x4 o0 = (f32x4){v[j][0], v[j][1], v[j][2], v[j][3]} * r * ga[j], o1 = (f32x4){v[j][4], v[j][5], v[j][6], v[j][7]} * r * gb[j];
            float* yr = out + O_Y + (size_t)row * D;
            *(f32x4*)(yr + (64 * j + lane) * 8) = o0; *(f32x4*)(yr + (64 * j + lane) * 8 + 4) = o1; }
    }
}

constexpr int LDS_BYTES = 147456;
extern "C" void kernel_launch(void* const* d_in, const int* in_sizes, int n_in, void* d_out, int out_size, void* d_ws, size_t ws_size, hipStream_t stream) {
    static int grid_blocks = 0;
    if (grid_blocks == 0) {
        if (n_in != 14 || ws_size < WS_END) { fprintf(stderr, "kernel_launch: unexpected problem (n_in %d, ws %zu)\n", n_in, ws_size); grid_blocks = -1; return; }
        int dev = 0, cus = 0, per_cu = 0;
        (void)hipGetDevice(&dev);
        (void)hipDeviceGetAttribute(&cus, hipDeviceAttributeMultiprocessorCount, dev);
        if (hipFuncSetAttribute((const void*)fwd_kernel, hipFuncAttributeMaxDynamicSharedMemorySize, LDS_BYTES) != hipSuccess) { fprintf(stderr, "kernel_launch: hipFuncSetAttribute failed\n"); grid_blocks = -1; return; }
        if (hipOccupancyMaxActiveBlocksPerMultiprocessor(&per_cu, (const void*)fwd_kernel, 512, LDS_BYTES) != hipSuccess || per_cu < 1) { fprintf(stderr, "kernel_launch: occupancy query failed or reports %d workgroups per CU; nothing launched\n", per_cu); (void)hipGetLastError(); grid_blocks = -1; return; }
        grid_blocks = cus * 1;
        if (grid_blocks != 256) { fprintf(stderr, "kernel_launch: built for a 256-CU device (static schedules), found %d CUs\n", cus); grid_blocks = -1; return; }
        fprintf(stderr, "kernel_launch: %d CUs, occupancy %d/CU, grid %d\n", cus, per_cu, grid_blocks);
    }
    if (grid_blocks < 0) return;
    (void)hipMemsetAsync((char*)d_ws + WS_CTL, 0, 262144, stream);
    Args a{};
    for (int i = 0; i < 14; ++i) a.in[i] = (const float*)d_in[i];
    a.out = (float*)d_out; a.ws = (unsigned char*)d_ws;
    void* args[] = {&a};
    hipError_t e = hipLaunchCooperativeKernel((const void*)fwd_kernel, dim3(grid_blocks), dim3(512), args, LDS_BYTES, stream);
    if (e != hipSuccess) fprintf(stderr, "cooperative launch failed: %s (grid %d)\n", hipGetErrorString(e), grid_blocks);
}
```

```cpp
#include <hip/hip_runtime.h>
#include <cstdio>
#include <cstdint>

#define LAS __attribute__((address_space(3)))
#define GAS __attribute__((address_space(1)))
typedef unsigned short bf16_t;
typedef short bf16x8 __attribute__((ext_vector_type(8)));
typedef float f32x4 __attribute__((ext_vector_type(4)));
typedef unsigned u32x4 __attribute__((ext_vector_type(4)));
typedef unsigned u32x2 __attribute__((ext_vector_type(2)));

constexpr int D = 1024, E = 2048, NB = 8, SEQ = 2048, DB = 128, DSEQ = 4;
constexpr int MP = NB * SEQ, MS = DB * DSEQ, M = MP + MS;
constexpr int N1 = 4 * E, N3 = 2 * E, GC = 512, PH = 15;
constexpr float EPS = 1e-6f;
constexpr size_t O_Y = 0, O_NCP = (size_t)M * D, O_NCS = O_NCP + (size_t)NB * 2 * E, O_NPP = O_NCS + (size_t)DB * 2 * E, O_NPS = O_NPP + (size_t)NB * PH * E;
constexpr size_t MiB = 1u << 20;
constexpr size_t WS_CTL = 0, WS_W4T = 1 * MiB, WS_W5T = 3 * MiB, WS_RS0 = 7 * MiB, WS_W3T = 8 * MiB, WS_XB = 16 * MiB, WS_SS1 = 49 * MiB;
constexpr size_t WS_HV = 53 * MiB, WS_PV = 69 * MiB;
constexpr size_t WS_B = 86 * MiB;
constexpr size_t WS_W1T = 152 * MiB;
constexpr size_t WS_HCV = 168 * MiB, WS_PGB = 171 * MiB, WS_PCV = 174 * MiB, WS_SCV = 177 * MiB, WS_SGB = 181 * MiB;
constexpr size_t WS_WUB = 185 * MiB;
constexpr size_t WS_W3U = 189 * MiB;
constexpr size_t WS_SPB = 193 * MiB;
constexpr size_t WS_HP = 201 * MiB;
constexpr size_t WS_SLAB = 217 * MiB;
constexpr size_t WS_PSZ = 233 * MiB;
constexpr size_t WS_SV = 242 * MiB, WS_SSZ = 246 * MiB;
constexpr size_t WS_W2T = 248 * MiB;
constexpr size_t WS_END = 252 * MiB;
constexpr int NRUN = MP / 128;
static_assert(WS_PV + (size_t)NRUN * 16 * E * 4 <= WS_B && WS_HV + (size_t)NRUN * PH * E * 4 <= WS_PV && WS_XB + (size_t)M * D * 2 <= WS_SS1 && WS_B + (size_t)M * E * 2 <= WS_W1T, "ws map 1");
static_assert(WS_SGB + (size_t)MS * E * 4 <= WS_WUB && WS_HP + (size_t)2048 * E * 4 <= WS_SLAB && WS_SLAB + (size_t)8 * MS * D * 4 <= WS_PSZ && WS_PSZ + (size_t)NRUN * 16 * E * 2 <= WS_SV && WS_SSZ + (size_t)MS * E * 2 <= WS_W2T, "ws map 2");

namespace pg8 {
constexpr int BM = 256, BK = 64, HALF = 128, HTB = HALF * BK * 2, STAGE_BYTES = 8 * HTB, NXCD = 8, WGM = 8;
__host__ __device__ __forceinline__ int lds_byte(int r, int c) { const int st = (r >> 4) * 2 + (c >> 5), rr = r & 15, cc = c & 31, ob = rr * 64 + cc * 2; return st * 1024 + (ob ^ (((ob >> 9) & 1) << 5)); }
__host__ __device__ __forceinline__ void stage_rc(int b, int& R, int& C) { const int st = b / 1024, sb = b % 1024, swz = sb ^ (((sb >> 9) & 1) << 5); R = (st >> 1) * 16 + swz / 64; C = (st & 1) * 32 + (swz % 64) / 2; }

struct Unit { int pm, pn, slot; };
struct Gemm { const bf16_t* A; const bf16_t* Bt; int M, N, K, lda, agshift, agstride, ldb, bgshift, bgstride; };

struct StaticOrder {
    int nM, nN, nwg, G, c;
    __device__ void init(int M_, int N_, int G_, int c_) { nM = M_ / BM; nN = N_ / BM; nwg = nM * nN; G = G_; c = c_; }
    __device__ bool next(int i, Unit& u) const {
        const long L = (long)i * G + c; if (L >= nwg) return false;
        int wgid = (int)L; { const int q = nwg / NXCD, r = nwg % NXCD, xcd = wgid % NXCD, off = wgid / NXCD; wgid = (xcd < r ? xcd * (q + 1) : r * (q + 1) + (xcd - r) * q) + off; }
        const int nig = WGM * nN, gid = wgid / nig, fm = gid * WGM, gsz = (nM - fm) < WGM ? (nM - fm) : WGM;
        u.pm = fm + ((wgid % nig) % gsz); u.pn = (wgid % nig) / gsz; u.slot = i & 1; return true;
    }
    __device__ __forceinline__ void a_ready(const Unit&) const {}
    __device__ __forceinline__ void done(const Unit&, int) const {}
};

__device__ __forceinline__ unsigned cvt_pk_bf16(float lo, float hi) { unsigned r; asm("v_cvt_pk_bf16_f32 %0, %1, %2" : "=v"(r) : "v"(lo), "v"(hi)); return r; }

template <class Epi, class Sched, bool ALIGN_EPI, bool SP2, int ROWPERM>
__device__ __forceinline__ void gemm_phase(LAS unsigned char* lds, const Gemm g, const Sched& S, const Epi& E) {
    int tid = threadIdx.x; asm volatile("" : "+v"(tid));
    const int wid = __builtin_amdgcn_readfirstlane(tid >> 6), lane = tid & 63, wr = wid >> 2, wc = wid & 3, fr = lane & 15, fq = lane >> 4;
    const int K = g.K, nt = K / BK, lda = g.lda;
    unsigned voffA[2], voffB[2];
#pragma unroll
    for (int i = 0; i < 2; ++i) { int R, C; stage_rc(tid * 16 + i * 8192, R, C); const int Ra = ROWPERM == 2 ? ((R >> 4) * 2048 + 2032 + (R & 15)) : ROWPERM == 1 ? (128 * ((R >> 6) & 1) + 8 * (R & 15) + ((R >> 4) & 3)) : R;
        voffA[i] = (unsigned)(Ra * lda + C) * 2u; voffB[i] = (unsigned)(R * g.ldb + C) * 2u; }
    const size_t kstep = (size_t)(BK * 2);
    const size_t tstepA = (size_t)BM * lda * 2, hstepA = ROWPERM == 2 ? (size_t)0 : ROWPERM == 1 ? (size_t)4 * lda * 2 : (size_t)HALF * lda * 2, hstepB = (size_t)HALF * g.ldb * 2;
    const unsigned ldsw = (unsigned)wid * 1024u;
    const int aoff = lds_byte(wr * 64 + fr, fq * 8), boff = lds_byte(wc * 32 + fr, fq * 8);
#define PG8_UA(u) ((const char*)g.A + (size_t)(u).pm * tstepA + (size_t)(((u).pn >> g.agshift) * g.agstride) * 2)
#define PG8_UB(u) ((const char*)g.Bt + (size_t)(u).pn * 2 * hstepB + (size_t)(((u).pm >> g.bgshift) * g.bgstride) * 2)
#define PG8_SA(b, h) (((b) * 2 + (h)) * HTB)
#define PG8_SB(b, h) ((4 + (b) * 2 + (h)) * HTB)
#define PG8_STAGE(bufoff, gbase, voff) do { _Pragma("unroll") for (int _i = 0; _i < 2; ++_i) \
        __builtin_amdgcn_global_load_lds((const unsigned*)((const char*)(gbase) + (voff)[_i]), (LAS unsigned*)(lds + (bufoff) + ldsw + _i * 8192), 16, 0, 0); } while (0)
#define PG8_LDA(dst, b, h) do { _Pragma("unroll") for (int m = 0; m < 4; ++m) _Pragma("unroll") for (int k = 0; k < 2; ++k) dst[m][k] = *(const LAS bf16x8*)(lds + PG8_SA(b, h) + aoff + m * 2048 + k * 1024); } while (0)
#define PG8_LDB(dst, b, h) do { _Pragma("unroll") for (int n = 0; n < 2; ++n) _Pragma("unroll") for (int k = 0; k < 2; ++k) dst[n][k] = *(const LAS bf16x8*)(lds + PG8_SB(b, h) + boff + n * 2048 + k * 1024); } while (0)
#define PG8_MMA(ai, bj, At, Bt) do { __builtin_amdgcn_s_setprio(1); _Pragma("unroll") for (int m = 0; m < 4; ++m) _Pragma("unroll") for (int n = 0; n < 2; ++n) _Pragma("unroll") for (int k = 0; k < 2; ++k) \
        acc[ai][bj][m][n] = __builtin_amdgcn_mfma_f32_16x16x32_bf16(Bt[n][k], At[m][k], acc[ai][bj][m][n], 0, 0, 0); __builtin_amdgcn_s_setprio(0); } while (0)
#define PG8_WAIT_V(n) asm volatile("s_waitcnt vmcnt(" #n ")" ::: "memory")
#define PG8_WAIT_L(n) asm volatile("s_waitcnt lgkmcnt(" #n ")" ::: "memory")
#define PG8_BAR __builtin_amdgcn_s_barrier()
#define PG8_SCHED __builtin_amdgcn_sched_barrier(0)
    Unit cur, nxt; int ui = 0;
    if (!S.next(0, cur)) return;
    f32x4 acc[2][2][4][2];
#pragma unroll
    for (int a = 0; a < 2; ++a)
#pragma unroll
        for (int b = 0; b < 2; ++b)
#pragma unroll
            for (int m = 0; m < 4; ++m)
#pragma unroll
                for (int n = 0; n < 2; ++n) acc[a][b][m][n] = (f32x4){0.f, 0.f, 0.f, 0.f};
    bf16x8 At[4][2], B0[2][2], B1[2][2];
    const char* cA = PG8_UA(cur); const char* cB = PG8_UB(cur);
    S.a_ready(cur);
    if constexpr (SP2) {
        PG8_STAGE(PG8_SB(0, 0), cB, voffB); PG8_STAGE(PG8_SB(0, 1), cB + hstepB, voffB); PG8_STAGE(PG8_SA(0, 0), cA, voffA); PG8_STAGE(PG8_SA(0, 1), cA + hstepA, voffA);
        if (wr == 1) PG8_BAR;
        PG8_WAIT_V(2); PG8_BAR;
        PG8_STAGE(PG8_SB(1, 0), cB + kstep, voffB); PG8_STAGE(PG8_SA(1, 0), cA + kstep, voffA); PG8_STAGE(PG8_SB(1, 1), cB + hstepB + kstep, voffB);
        PG8_WAIT_V(6); PG8_BAR;
    } else {
        PG8_STAGE(PG8_SB(0, 0), cB, voffB); PG8_STAGE(PG8_SA(0, 0), cA, voffA); PG8_STAGE(PG8_SB(0, 1), cB + hstepB, voffB); PG8_STAGE(PG8_SA(0, 1), cA + hstepA, voffA);
        if (wr == 1) PG8_BAR;
        PG8_WAIT_V(4); PG8_BAR;
        PG8_STAGE(PG8_SB(1, 0), cB + kstep, voffB); PG8_STAGE(PG8_SA(1, 0), cA + kstep, voffA); PG8_STAGE(PG8_SB(1, 1), cB + hstepB + kstep, voffB);
        PG8_WAIT_V(6); PG8_BAR;
    }
    for (;;) {
        const bool has_next = S.next(ui + 1, nxt);
        const char* nA = has_next ? PG8_UA(nxt) : cA; const char* nB = has_next ? PG8_UB(nxt) : cB;
        for (int t = 0; t < nt; t += 2) {
            const bool last = (t == nt - 2);
            const char* a1 = cA + (size_t)(t + 1) * kstep;
            const char* a2 = last ? nA : cA + (size_t)(t + 2) * kstep; const char* b2 = last ? nB : cB + (size_t)(t + 2) * kstep;
            const char* a3 = a2 + kstep; const char* b3 = b2 + kstep;
            if (last && has_next) S.a_ready(nxt);
            if constexpr (SP2) {
            PG8_LDB(B0, 0, 0); PG8_LDB(B1, 0, 1); PG8_SCHED; PG8_LDA(At, 0, 0); PG8_STAGE(PG8_SA(1, 1), a1 + hstepA, voffA);
            PG8_WAIT_V(8); PG8_WAIT_L(0); PG8_BAR; PG8_MMA(0, 0, At, B0); PG8_MMA(0, 1, At, B1); PG8_BAR; PG8_SCHED;
            PG8_LDA(At, 0, 1); PG8_STAGE(PG8_SB(0, 0), b2, voffB); PG8_STAGE(PG8_SB(0, 1), b2 + hstepB, voffB); PG8_STAGE(PG8_SA(0, 0), a2, voffA);
            PG8_WAIT_V(8); PG8_WAIT_L(0); PG8_BAR; PG8_MMA(1, 0, At, B0); PG8_MMA(1, 1, At, B1); PG8_BAR; PG8_SCHED;
            PG8_LDB(B0, 1, 0); PG8_LDB(B1, 1, 1); PG8_SCHED; PG8_LDA(At, 1, 0); PG8_STAGE(PG8_SA(0, 1), a2 + hstepA, voffA);
            PG8_WAIT_V(8); PG8_WAIT_L(0); PG8_BAR; PG8_MMA(0, 0, At, B0); PG8_MMA(0, 1, At, B1); PG8_BAR; PG8_SCHED;
            PG8_LDA(At, 1, 1); PG8_STAGE(PG8_SB(1, 0), b3, voffB); PG8_STAGE(PG8_SB(1, 1), b3 + hstepB, voffB); PG8_STAGE(PG8_SA(1, 0), a3, voffA);
            PG8_WAIT_V(8); PG8_WAIT_L(0); PG8_BAR; PG8_MMA(1, 0, At, B0); PG8_MMA(1, 1, At, B1); PG8_BAR; PG8_SCHED;
            } else {
            PG8_LDB(B0, 0, 0); PG8_SCHED; PG8_LDA(At, 0, 0); PG8_STAGE(PG8_SA(1, 1), a1 + hstepA, voffA);
            PG8_WAIT_L(8); PG8_BAR; PG8_WAIT_L(0); PG8_MMA(0, 0, At, B0); PG8_BAR; PG8_SCHED;
            PG8_LDB(B1, 0, 1); PG8_STAGE(PG8_SB(0, 0), b2, voffB);
            PG8_BAR; PG8_WAIT_L(0); PG8_MMA(0, 1, At, B1); PG8_BAR;
            PG8_LDA(At, 0, 1); PG8_STAGE(PG8_SA(0, 0), a2, voffA);
            PG8_BAR; PG8_WAIT_L(0); PG8_MMA(1, 0, At, B0); PG8_BAR; PG8_SCHED;
            PG8_STAGE(PG8_SB(0, 1), b2 + hstepB, voffB);
            PG8_WAIT_V(6); PG8_BAR; PG8_MMA(1, 1, At, B1); PG8_BAR;
            PG8_LDB(B0, 1, 0); PG8_SCHED; PG8_LDA(At, 1, 0); PG8_STAGE(PG8_SA(0, 1), a2 + hstepA, voffA);
            PG8_WAIT_L(8); PG8_BAR; PG8_WAIT_L(0); PG8_MMA(0, 0, At, B0); PG8_BAR; PG8_SCHED;
            PG8_LDB(B1, 1, 1); PG8_STAGE(PG8_SB(1, 0), b3, voffB);
            PG8_BAR; PG8_WAIT_L(0); PG8_MMA(0, 1, At, B1); PG8_BAR;
            PG8_LDA(At, 1, 1); PG8_STAGE(PG8_SA(1, 0), a3, voffA);
            PG8_BAR; PG8_WAIT_L(0); PG8_MMA(1, 0, At, B0); PG8_BAR; PG8_SCHED;
            PG8_STAGE(PG8_SB(1, 1), b3 + hstepB, voffB);
            PG8_WAIT_V(6); PG8_BAR; PG8_MMA(1, 1, At, B1); PG8_BAR;
            }
        }
        if constexpr (ALIGN_EPI) { if (wr == 0) PG8_BAR; }
        E(acc, cur, wr, wc, fr, fq); S.done(cur, lane);
        if (!has_next) break;
#pragma unroll
        for (int a = 0; a < 2; ++a)
#pragma unroll
            for (int b = 0; b < 2; ++b)
#pragma unroll
                for (int m = 0; m < 4; ++m)
#pragma unroll
                    for (int n = 0; n < 2; ++n) acc[a][b][m][n] = (f32x4){0.f, 0.f, 0.f, 0.f};
        cur = nxt; cA = nA; cB = nB; ++ui;
        if constexpr (ALIGN_EPI) { if (wr == 1) PG8_BAR; }
    }
    PG8_WAIT_V(0);
    if constexpr (!ALIGN_EPI) { if (wr == 0) PG8_BAR; }
    PG8_BAR;
#undef PG8_UA
#undef PG8_UB
#undef PG8_SA
#undef PG8_SB
#undef PG8_STAGE
#undef PG8_LDA
#undef PG8_LDB
#undef PG8_MMA
#undef PG8_WAIT_V
#undef PG8_WAIT_L
#undef PG8_BAR
#undef PG8_SCHED
}
}

using pg8::Unit; using pg8::cvt_pk_bf16;
#define LDS_WAIT() asm volatile("s_waitcnt lgkmcnt(0)" ::: "memory")
__device__ __forceinline__ float sigm(float z) { return __builtin_amdgcn_rcpf(1.0f + __builtin_amdgcn_exp2f(-1.4426950408889634f * z)); }
__device__ __forceinline__ float bflo(unsigned w) { return __builtin_bit_cast(float, w << 16); }
__device__ __forceinline__ float bfhi(unsigned w) { return __builtin_bit_cast(float, w & 0xffff0000u); }
__device__ __forceinline__ void bf8_to_f32(const u32x4 w, float (&f)[8]) { f[0] = bflo(w.x); f[1] = bfhi(w.x); f[2] = bflo(w.y); f[3] = bfhi(w.y); f[4] = bflo(w.z); f[5] = bfhi(w.z); f[6] = bflo(w.w); f[7] = bfhi(w.w); }
__device__ __forceinline__ u32x4 f32_to_bf8(const float (&f)[8]) { u32x4 w; w.x = cvt_pk_bf16(f[0], f[1]); w.y = cvt_pk_bf16(f[2], f[3]); w.z = cvt_pk_bf16(f[4], f[5]); w.w = cvt_pk_bf16(f[6], f[7]); return w; }
__device__ __forceinline__ float dpp_add(float v, const int ctrl_sel) {
    const int x = __builtin_bit_cast(int, v); int y;
    if (ctrl_sel == 0) y = __builtin_amdgcn_update_dpp(0, x, 0xB1, 0xf, 0xf, true);
    else if (ctrl_sel == 1) y = __builtin_amdgcn_update_dpp(0, x, 0x4E, 0xf, 0xf, true);
    else if (ctrl_sel == 2) y = __builtin_amdgcn_update_dpp(0, x, 0x141, 0xf, 0xf, true);
    else y = __builtin_amdgcn_update_dpp(0, x, 0x140, 0xf, 0xf, true);
    return v + __builtin_bit_cast(float, y);
}
__device__ __forceinline__ float wave_sum(float v) {
    v = dpp_add(v, 0); v = dpp_add(v, 1); v = dpp_add(v, 2); v = dpp_add(v, 3);
    const int x = __builtin_bit_cast(int, v);
    const float a = __builtin_bit_cast(float, __builtin_amdgcn_readlane(x, 0)), b = __builtin_bit_cast(float, __builtin_amdgcn_readlane(x, 16));
    const float c = __builtin_bit_cast(float, __builtin_amdgcn_readlane(x, 32)), d = __builtin_bit_cast(float, __builtin_amdgcn_readlane(x, 48));
    return (a + b) + (c + d);
}

__device__ __forceinline__ int dest_row(int kind, int n) {
    if (kind == 0) { const int part = n >> 11, e = n & 2047, pn = e >> 6, el = e & 63; const int cg = (el >> 2) & 3, sg = ((cg & 1) << 1) | (cg >> 1); return pn * 256 + (part >> 1) * 128 + (el >> 4) * 32 + (part & 1) * 16 + sg * 4 + (el & 3); }
    if (kind == 1) { const int part = n >> 11, e = n & 2047, pn = e >> 7, el = e & 127; return pn * 256 + part * 128 + (el >> 5) * 32 + ((el >> 2) & 1) * 16 + ((el >> 3) & 3) * 4 + (el & 3); }
    const int cl = n & 255; return (n & ~255) + (cl & 0xE0) + ((cl >> 2) & 1) * 16 + ((cl >> 3) & 3) * 4 + (cl & 3);
}
__device__ __forceinline__ void prompt_unit(int L, int nN, Unit& u) {
    const int per = 8 * nN, w = (L & 7) * per + (L >> 3), r = w % per;
    u.pm = (w / per) * 8 + (r & 7); u.pn = r >> 3;
}
__device__ __forceinline__ void wait_count(const unsigned* cnt, unsigned need) {
    if (threadIdx.x < 64) {
        unsigned sp = 0;
        while ((unsigned)__builtin_amdgcn_readfirstlane(__hip_atomic_load(cnt, __ATOMIC_RELAXED, __HIP_MEMORY_SCOPE_AGENT)) < need) { __builtin_amdgcn_s_sleep(2); if (++sp > (1u << 21)) break; }
        __builtin_amdgcn_fence(__ATOMIC_ACQUIRE, "agent");
        asm volatile("s_waitcnt vmcnt(0)" ::: "memory");
    }
    asm volatile("" ::: "memory"); __builtin_amdgcn_s_barrier(); asm volatile("" ::: "memory");
}
__device__ __forceinline__ void count_in(unsigned* cnt, int lane) {
    asm volatile("s_waitcnt vmcnt(0)" ::: "memory");
    if (lane == 0) __hip_atomic_fetch_add(cnt, 1u, __ATOMIC_RELAXED, __HIP_MEMORY_SCOPE_AGENT);
}

typedef __amdgpu_buffer_rsrc_t rsrc_t;
__device__ __forceinline__ rsrc_t mk_rsrc(const void* p, unsigned bytes) { return __builtin_amdgcn_make_buffer_rsrc((void*)p, 0, bytes, 0x00020000); }
__device__ __forceinline__ void st16_wt(rsrc_t r, unsigned byte_off, u32x4 v) { __builtin_amdgcn_raw_buffer_store_b128(v, r, byte_off, 0, 16); }
__device__ __forceinline__ void st8_wt(void* p, u32x2 v) { __hip_atomic_store((unsigned long long*)p, __builtin_bit_cast(unsigned long long, v), __ATOMIC_RELAXED, __HIP_MEMORY_SCOPE_AGENT); }
__device__ __forceinline__ float dpp_shr1(float v) { return __builtin_bit_cast(float, __builtin_amdgcn_update_dpp(0, __builtin_bit_cast(int, v), 0x111, 0xf, 0xf, true)); }
__device__ __forceinline__ float dpp_shr2(float v) { return __builtin_bit_cast(float, __builtin_amdgcn_update_dpp(0, __builtin_bit_cast(int, v), 0x112, 0xf, 0xf, true)); }
__device__ __forceinline__ void st_pair(bf16_t* Y0, int t, int e0, int hi32, u32x2 a, u32x2 b) {
    const auto rx = __builtin_amdgcn_permlane32_swap(a.x, b.x, false, false), ry = __builtin_amdgcn_permlane32_swap(a.y, b.y, false, false);
    *(u32x4*)(Y0 + (size_t)(t + hi32) * E + (e0 - 4 * hi32)) = (u32x4){rx[0], ry[0], rx[1], ry[1]};
}
struct Epi1 {
    LAS unsigned char* tab; bf16_t* Y0; float* HCV; float* PGB; float* PCV; const float* st_conv; float* out;
    __device__ __forceinline__ void operator()(const f32x4 (&acc)[2][2][4][2], const Unit& u, int wr, int wc, int fr, int fq) const {
        const int cgq = ((fq & 1) << 1) | (fq >> 1);
        const int e0 = u.pn * 64 + wc * 16 + cgq * 4;
        const int t0 = u.pm * 256 + wr * 128 + fr * 8, hi32 = fq >> 1;
        const LAS unsigned char* tb = tab + (u.slot & 1) * 2048;
        const f32x4 ra = *(const LAS f32x4*)(tb + (wr * 128 + fr * 8) * 4), rb = *(const LAS f32x4*)(tb + (wr * 128 + fr * 8) * 4 + 16);
        f32x4 cv[8], g[8];
#pragma unroll
        for (int i = 0; i < 8; ++i) {
            const float r = i < 4 ? ra[i & 3] : rb[i & 3];
            const f32x4 gb = acc[i >> 2][0][i & 3][0] * r, gc = acc[i >> 2][0][i & 3][1] * r, v = acc[i >> 2][1][i & 3][0] * r, z = acc[i >> 2][1][i & 3][1] * r;
            cv[i] = gc * v;
#pragma unroll
            for (int j = 0; j < 4; ++j) g[i][j] = gb[j] * z[j] * sigm(z[j]);
        }
        const LAS f32x4* wp = (const LAS f32x4*)(tb + 1024 + (wc * 16 + cgq * 4) * 4);
        const f32x4 w0 = wp[0], w1 = wp[16], w2 = wp[32], bb = wp[48];
        if (u.pm >= MP / 256) {
            const int s0 = t0 - MP, b0 = s0 >> 2;
#pragma unroll
            for (int q = 0; q < 2; ++q) {
                const float* st = st_conv + ((size_t)(b0 + q) * 2) * E + e0;
                const f32x4 h0 = *(const f32x4*)st, h1 = *(const f32x4*)(st + E);
                u32x2 w[4];
#pragma unroll
                for (int k = 0; k < 4; ++k) { const int i = 4 * q + k;
                    const f32x4 cm2 = k >= 2 ? cv[i - 2] : (k == 0 ? h0 : h1), cm1 = k >= 1 ? cv[i - 1] : h1;
                    const f32x4 y = g[i] * (bb + w0 * cm2 + w1 * cm1 + w2 * cv[i]);
                    w[k].x = cvt_pk_bf16(y[0], y[1]); w[k].y = cvt_pk_bf16(y[2], y[3]); }
                st_pair(Y0, t0 + 4 * q, e0, hi32, w[0], w[1]); st_pair(Y0, t0 + 4 * q + 2, e0, hi32, w[2], w[3]);
                float* o = out + O_NCS + ((size_t)(b0 + q) * 2) * E + e0;
                *(f32x4*)o = cv[4 * q + 2]; *(f32x4*)(o + E) = cv[4 * q + 3];
            }
            return;
        }
        f32x4 hm2, hm1;
#pragma unroll
        for (int j = 0; j < 4; ++j) { hm2[j] = dpp_shr1(cv[6][j]); hm1[j] = dpp_shr1(cv[7][j]); }
#pragma unroll
        for (int i = 0; i < 8; i += 2) {
            u32x2 w[2];
#pragma unroll
            for (int k = 0; k < 2; ++k) { const int t = i + k;
                const f32x4 cm2 = t >= 2 ? cv[t - 2] : (t == 0 ? hm2 : hm1), cm1 = t >= 1 ? cv[t - 1] : hm1;
                const f32x4 y = g[t] * (bb + w0 * cm2 + w1 * cm1 + w2 * cv[t]);
                w[k].x = cvt_pk_bf16(y[0], y[1]); w[k].y = cvt_pk_bf16(y[2], y[3]); }
            if (i >= 2 || fr != 0) st_pair(Y0, t0 + i, e0, hi32, w[0], w[1]);
        }
        const int run = 2 * u.pm + wr;
        if (fr == 0) {
            *(f32x4*)(PGB + ((size_t)run * 2 + 0) * E + e0) = g[0]; *(f32x4*)(PGB + ((size_t)run * 2 + 1) * E + e0) = g[1];
            *(f32x4*)(PCV + ((size_t)run * 2 + 0) * E + e0) = cv[0]; *(f32x4*)(PCV + ((size_t)run * 2 + 1) * E + e0) = cv[1];
        }
        if (fr == 15) {
            *(f32x4*)(HCV + ((size_t)run * 2 + 0) * E + e0) = cv[6]; *(f32x4*)(HCV + ((size_t)run * 2 + 1) * E + e0) = cv[7];
            if ((run & 15) == 15) { *(f32x4*)(out + O_NCP + ((size_t)(run >> 4) * 2 + 0) * E + e0) = cv[6]; *(f32x4*)(out + O_NCP + ((size_t)(run >> 4) * 2 + 1) * E + e0) = cv[7]; }
        }
    }
};
template <bool SSQ> struct EpiRes {
    bf16_t* XB; float* ssp;
    __device__ __forceinline__ void operator()(const f32x4 (&acc)[2][2][4][2], const Unit& u, int wr, int wc, int fr, int fq) const {
        const int col0 = u.pn * 256 + wc * 32 + fq * 8;
        const rsrc_t rx = mk_rsrc(XB, (unsigned)((size_t)M * D * 2));
#pragma unroll
        for (int ai = 0; ai < 2; ++ai)
#pragma unroll
            for (int m = 0; m < 4; ++m) {
                const int row = u.pm * 256 + ai * 128 + wr * 64 + m * 16 + fr;
                float ss = 0.f;
#pragma unroll
                for (int bj = 0; bj < 2; ++bj) {
                    const size_t off = (size_t)row * D + col0 + bj * 128;
                    float x[8]; bf8_to_f32(*(const u32x4*)(XB + off), x);
                    const f32x4 a0 = acc[ai][bj][m][0], a1 = acc[ai][bj][m][1];
                    float v[8];
#pragma unroll
                    for (int j = 0; j < 4; ++j) { v[j] = x[j] + a0[j]; v[4 + j] = x[4 + j] + a1[j]; }
                    if (SSQ) ss += ((v[0] * v[0] + v[1] * v[1]) + (v[2] * v[2] + v[3] * v[3])) + ((v[4] * v[4] + v[5] * v[5]) + (v[6] * v[6] + v[7] * v[7]));
                    st16_wt(rx, (unsigned)(off * 2), f32_to_bf8(v));
                }
                if (SSQ) { ss += __shfl_xor(ss, 16); ss += __shfl_xor(ss, 32);
                    if (fq == 0) __hip_atomic_store(ssp + (size_t)row * 16 + u.pn * 4 + wc, ss, __ATOMIC_RELAXED, __HIP_MEMORY_SCOPE_AGENT); }
            }
    }
};
struct EpiG5 {
    const bf16_t* XB; float* xs; unsigned* cnt; const float* gfin; float* outy; LAS unsigned char* tab; LAS unsigned char* stage;
    __device__ __forceinline__ void operator()(const f32x4 (&acc)[2][2][4][2], const Unit& u, int wr, int wc, int fr, int fq) const {
        const int col0 = u.pn * 256 + wc * 32 + fq * 8;
        f32x4 v[2][4][2][2];
#pragma unroll
        for (int ai = 0; ai < 2; ++ai)
#pragma unroll
            for (int m = 0; m < 4; ++m) {
                const int row = u.pm * 256 + ai * 128 + wr * 64 + m * 16 + fr;
                float ss = 0.f;
#pragma unroll
                for (int bj = 0; bj < 2; ++bj) {
                    float x[8]; bf8_to_f32(*(const u32x4*)(XB + (size_t)row * D + col0 + bj * 128), x);
                    const f32x4 a0 = acc[ai][bj][m][0], a1 = acc[ai][bj][m][1];
                    f32x4 v0, v1;
#pragma unroll
                    for (int j = 0; j < 4; ++j) { v0[j] = x[j] + a0[j]; v1[j] = x[4 + j] + a1[j]; }
                    ss += ((v0[0] * v0[0] + v0[1] * v0[1]) + (v0[2] * v0[2] + v0[3] * v0[3])) + ((v1[0] * v1[0] + v1[1] * v1[1]) + (v1[2] * v1[2] + v1[3] * v1[3]));
                    v[ai][m][bj][0] = v0; v[ai][m][bj][1] = v1;
                }
                ss += __shfl_xor(ss, 16); ss += __shfl_xor(ss, 32);
                if (fq == 0) __hip_atomic_store(xs + (size_t)row * 16 + u.pn * 4 + wc, ss, __ATOMIC_RELAXED, __HIP_MEMORY_SCOPE_AGENT);
            }
        asm volatile("s_waitcnt vmcnt(0)" ::: "memory"); __builtin_amdgcn_s_barrier();
        if (threadIdx.x == 0) __hip_atomic_fetch_add(cnt + 64 * u.pm, 1u, __ATOMIC_RELAXED, __HIP_MEMORY_SCOPE_AGENT);
        LAS unsigned char* stg = stage + (wr * 4 + wc) * 16384;
#pragma unroll
        for (int m = 0; m < 4; ++m)
#pragma unroll
            for (int bj = 0; bj < 2; ++bj)
#pragma unroll
                for (int h = 0; h < 2; ++h) *(LAS f32x4*)(stg + (m * 16 + fr) * 256 + (((bj * 8 + fq * 2 + h) ^ fr) << 4)) = v[0][m][bj][h];
        wait_count(cnt + 64 * u.pm, 4u);
        { const int t = threadIdx.x;
          if (t < 256) { const f32x4* sp = (const f32x4*)(xs + ((size_t)u.pm * 256 + t) * 16);
              const f32x4 st = (sp[0] + sp[1]) + (sp[2] + sp[3]);
              *(LAS float*)(tab + t * 4) = rsqrtf(((st[0] + st[1]) + (st[2] + st[3])) * (1.0f / D) + EPS); } }
        asm volatile("s_waitcnt lgkmcnt(0)" ::: "memory"); __builtin_amdgcn_s_barrier(); asm volatile("" ::: "memory");
        const int lane = fq * 16 + fr, c = lane & 15, rq = lane >> 4;
        const int colL = u.pn * 256 + (c >> 3) * 128 + wc * 32 + (c & 7) * 4;
        const f32x4 gl = *(const f32x4*)(gfin + colL);
#pragma unroll
        for (int ai = 0; ai < 2; ++ai) {
            if (ai == 1) {
#pragma unroll
                for (int m = 0; m < 4; ++m)
#pragma unroll
                    for (int bj = 0; bj < 2; ++bj)
#pragma unroll
                        for (int h = 0; h < 2; ++h) *(LAS f32x4*)(stg + (m * 16 + fr) * 256 + (((bj * 8 + fq * 2 + h) ^ fr) << 4)) = v[1][m][bj][h];
            }
            asm volatile("s_waitcnt lgkmcnt(0)" ::: "memory");
#pragma unroll
            for (int k = 0; k < 16; ++k) {
                const int r = k * 4 + rq, rl = ai * 128 + wr * 64 + r;
                const f32x4 val = *(const LAS f32x4*)(stg + r * 256 + ((c ^ (r & 15)) << 4));
                const float rs = *(const LAS float*)(tab + rl * 4);
                *(f32x4*)(outy + (size_t)(u.pm * 256 + rl) * D + colL) = val * rs * gl;
            }
            asm volatile("s_waitcnt lgkmcnt(0)" ::: "memory");
        }
    }
};
template <int W> __device__ __forceinline__ void pool_lane(const float (&x)[8], float (&p)[8]) {
    float pre[8]; pre[0] = x[0];
#pragma unroll
    for (int i = 1; i < 8; ++i) pre[i] = pre[i - 1] + x[i];
    const float S = pre[7];
    float win[8];
    if (W == 2) {
        const float h = dpp_shr1(x[7]);
#pragma unroll
        for (int i = 0; i < 8; ++i) win[i] = x[i] + (i >= 1 ? x[i - 1] : h);
    } else if (W == 4) {
#pragma unroll
        for (int i = 0; i < 8; ++i) win[i] = i >= 4 ? pre[i] - pre[i - 4] : (i == 3 ? pre[3] : pre[i] + dpp_shr1(S - pre[i + 4]));
    } else if (W == 8) {
#pragma unroll
        for (int i = 0; i < 8; ++i) win[i] = i == 7 ? pre[7] : pre[i] + dpp_shr1(S - pre[i]);
    } else {
        const float s1 = dpp_shr1(S);
#pragma unroll
        for (int i = 0; i < 8; ++i) win[i] = i == 7 ? pre[7] + s1 : pre[i] + s1 + dpp_shr2(S - pre[i]);
    }
#pragma unroll
    for (int i = 0; i < 8; ++i) p[i] = win[i] * (1.0f / W) - x[i];
}
struct Epi3 {
    LAS unsigned char* rsb;
    bf16_t* Y1; float* HV; float* PV; bf16_t* PSZ; float* SV; bf16_t* SSZ;
    __device__ __forceinline__ void operator()(const f32x4 (&acc)[2][2][4][2], const Unit& u, int wr, int wc, int fr, int fq) const {
        const int e0 = u.pn * 128 + wc * 32 + fq * 8;
        const int t0 = u.pm * 256 + wr * 128 + fr * 8;
        float r[8];
        { const LAS f32x4* rp = (const LAS f32x4*)(rsb + (u.slot & 1) * 1024 + (wr * 128 + fr * 8) * 4); const f32x4 r0 = rp[0], r1 = rp[1];
#pragma unroll
          for (int i = 0; i < 4; ++i) { r[i] = r0[i]; r[4 + i] = r1[i]; } }
        u32x4 szp[8];
#pragma unroll
        for (int i = 0; i < 8; ++i) {
            const f32x4 z0 = acc[i >> 2][1][i & 3][0] * r[i], z1 = acc[i >> 2][1][i & 3][1] * r[i];
            float sz[8];
#pragma unroll
            for (int j = 0; j < 4; ++j) { sz[j] = z0[j] * sigm(z0[j]); sz[4 + j] = z1[j] * sigm(z1[j]); }
            szp[i] = f32_to_bf8(sz);
        }
        f32x4 ua[8], ub[8];
#pragma unroll
        for (int i = 0; i < 8; ++i) { ua[i] = acc[i >> 2][0][i & 3][0] * r[i]; ub[i] = acc[i >> 2][0][i & 3][1] * r[i]; }
        if (u.pm >= MP / 256) {
            const int s0 = t0 - MP;
            const rsrc_t svr = mk_rsrc(SV, (unsigned)((size_t)MS * E * 4)), szr = mk_rsrc(SSZ, (unsigned)((size_t)MS * E * 2));
#pragma unroll
            for (int i = 0; i < 8; ++i) { const unsigned o = (unsigned)((size_t)(s0 + i) * E + e0);
                st16_wt(svr, o * 4, __builtin_bit_cast(u32x4, ua[i])); st16_wt(svr, o * 4 + 16, __builtin_bit_cast(u32x4, ub[i])); st16_wt(szr, o * 2, szp[i]); }
            return;
        }
        const int run = 2 * u.pm + wr;
        if (fr < 2) {
            const rsrc_t pvr = mk_rsrc(PV, (unsigned)((size_t)NRUN * 16 * E * 4)), pzr = mk_rsrc(PSZ, (unsigned)((size_t)NRUN * 16 * E * 2));
#pragma unroll
            for (int i = 0; i < 8; ++i) { const unsigned o = (unsigned)(((size_t)run * 16 + fr * 8 + i) * E + e0);
                st16_wt(pvr, o * 4, __builtin_bit_cast(u32x4, ua[i])); st16_wt(pvr, o * 4 + 16, __builtin_bit_cast(u32x4, ub[i])); st16_wt(pzr, o * 2, szp[i]); }
        }
        if (fr >= 14) {
            const rsrc_t hvr = mk_rsrc(HV, (unsigned)((size_t)NRUN * PH * E * 4));
#pragma unroll
            for (int i = 0; i < 8; ++i) { const int idx = fr * 8 + i - (128 - PH);
                if (idx >= 0) { const unsigned o = (unsigned)((((size_t)run * PH + idx) * E + e0) * 4); st16_wt(hvr, o, __builtin_bit_cast(u32x4, ua[i])); st16_wt(hvr, o + 16, __builtin_bit_cast(u32x4, ub[i])); } }
        }
        float pp[8][8];
        const int grp = u.pn >> 2;
#pragma unroll
        for (int c = 0; c < 8; ++c) {
            float x[8], p[8];
#pragma unroll
            for (int i = 0; i < 8; ++i) x[i] = c < 4 ? ua[i][c & 3] : ub[i][c & 3];
            if (grp == 0) pool_lane<2>(x, p); else if (grp == 1) pool_lane<4>(x, p); else if (grp == 2) pool_lane<8>(x, p); else pool_lane<16>(x, p);
#pragma unroll
            for (int i = 0; i < 8; ++i) pp[i][c] = p[i];
        }
        if (fr >= 2) {
            const rsrc_t y1r = mk_rsrc(Y1, (unsigned)((size_t)M * E * 2));
#pragma unroll
            for (int i = 0; i < 8; ++i) { float f[8]; bf8_to_f32(szp[i], f);
#pragma unroll
                for (int c = 0; c < 8; ++c) f[c] *= pp[i][c];
                st16_wt(y1r, (unsigned)(((size_t)(t0 + i) * E + e0) * 2), f32_to_bf8(f)); }
        }
    }
};
struct EpiWp {
    bf16_t* W3T;
    __device__ __forceinline__ void operator()(const f32x4 (&acc)[2][2][4][2], const Unit& u, int wr, int wc, int fr, int fq) const {
#pragma unroll
        for (int ai = 0; ai < 2; ++ai)
#pragma unroll
            for (int m = 0; m < 4; ++m) {
                const int e = u.pm * 256 + ai * 128 + wr * 64 + (m >> 1) * 32 + (fr >> 2) * 8 + (m & 1) * 4 + (fr & 3);
                bf16_t* rowp = W3T + (size_t)dest_row(1, e) * D + u.pn * 256 + wc * 32 + fq * 4;
#pragma unroll
                for (int bj = 0; bj < 2; ++bj)
#pragma unroll
                    for (int n = 0; n < 2; ++n) { const f32x4 v = acc[ai][bj][m][n]; u32x2 w; w.x = cvt_pk_bf16(v[0], v[1]); w.y = cvt_pk_bf16(v[2], v[3]); *(u32x2*)(rowp + bj * 128 + n * 16) = w; }
            }
    }
};
template <bool GATHER> struct EpiU {
    const float* ssp1; float* out;
    __device__ __forceinline__ void operator()(const f32x4 (&acc)[2][2][4][2], const Unit& u, int wr, int wc, int fr, int fq) const {
        const int col0 = u.pn * 256 + wc * 32 + fq * 8;
#pragma unroll
        for (int ai = 0; ai < (GATHER ? 1 : 2); ++ai)
#pragma unroll
            for (int m = 0; m < 4; ++m) {
                int row; float* dst; bool ok = true;
                if (GATHER) { const int b = wr * 4 + m; row = b * SEQ + (SEQ - 16) + fr; ok = fr >= 1; dst = out + O_NPP + ((size_t)b * PH + (fr >= 1 ? fr - 1 : 0)) * E; }
                else { row = u.pm * 256 + ai * 128 + wr * 64 + m * 16 + fr; const int rsn = row - MP; dst = out + O_NPS + ((size_t)(rsn >> 2) * PH + (PH - DSEQ) + (rsn & 3)) * E; }
                const f32x4* sp = (const f32x4*)(ssp1 + (size_t)row * 16);
                const f32x4 st = (sp[0] + sp[1]) + (sp[2] + sp[3]);
                const float r = rsqrtf(((st[0] + st[1]) + (st[2] + st[3])) * (1.0f / D) + EPS);
                if (ok) {
#pragma unroll
                    for (int bj = 0; bj < 2; ++bj) { *(f32x4*)(dst + col0 + bj * 128) = acc[ai][bj][m][0] * r; *(f32x4*)(dst + col0 + bj * 128 + 4) = acc[ai][bj][m][1] * r; } }
            }
    }
};
struct EpiHist {
    float* HP;
    __device__ __forceinline__ void operator()(const f32x4 (&acc)[2][2][4][2], const Unit& u, int wr, int wc, int fr, int fq) const {
        const int col0 = u.pn * 256 + wc * 32 + fq * 8;
        const rsrc_t hr = mk_rsrc(HP, (unsigned)((size_t)2048 * E * 4));
#pragma unroll
        for (int ai = 0; ai < 2; ++ai)
#pragma unroll
            for (int m = 0; m < 4; ++m) { const unsigned ro = (unsigned)(((size_t)(u.pm * 256 + ai * 128 + wr * 64 + m * 16 + fr) * E + col0) * 4);
#pragma unroll
                for (int bj = 0; bj < 2; ++bj) { st16_wt(hr, ro + bj * 512, __builtin_bit_cast(u32x4, acc[ai][bj][m][0])); st16_wt(hr, ro + bj * 512 + 16, __builtin_bit_cast(u32x4, acc[ai][bj][m][1])); } }
    }
};

#define XB_TMO      128
#define XB_XCNT(j)  (256  + 64 * (j))
#define XB_XSUB(j)  (1280 + 64 * (j))
#define XB_XGEN(j)  (2304 + 64 * (j))
#define XB_TOP      3328
#define XB_TOPGEN   3392
#define XCD_BAR_WORDS 3456
#define XB_SPIN_CAP (1u << 18)
__device__ __forceinline__ unsigned xb_ld(unsigned* p)              { return __hip_atomic_load(p, __ATOMIC_RELAXED, __HIP_MEMORY_SCOPE_AGENT); }
__device__ __forceinline__ unsigned xb_add(unsigned* p, unsigned v) { return __hip_atomic_fetch_add(p, v, __ATOMIC_RELAXED, __HIP_MEMORY_SCOPE_AGENT); }
__device__ __forceinline__ unsigned xb_xcc_id() { return (unsigned)__builtin_amdgcn_s_getreg((3 << 11) | 20) & 0xFu; }
#define XB_SPIN(cond, bar) do { unsigned _sp = 0; while (cond) { __builtin_amdgcn_s_sleep(1); \
    if ((++_sp & 255u) == 0u) { if (xb_ld(&(bar)[XB_TMO])) break; if (_sp > XB_SPIN_CAP) { atomicAdd(&(bar)[XB_TMO], 1u); break; } } } } while (0)
struct XcdBarrier { unsigned* bar; unsigned x; volatile LAS unsigned* st; };
__device__ __forceinline__ XcdBarrier xcd_barrier_post(unsigned* bar, volatile LAS unsigned* st) {
    XcdBarrier b; b.bar = bar; b.x = xb_xcc_id(); b.st = st;
    if (threadIdx.x == 0) (void)xb_add(&bar[XB_XCNT(b.x)], 1u);
    return b;
}
__device__ __forceinline__ void xcd_barrier_complete(unsigned* bar, unsigned x, unsigned& nloc, unsigned& nx) {
    const unsigned G = gridDim.x * gridDim.y * gridDim.z;
    unsigned sum, cnt, mine, sp = 0u;
    for (;;) {
        sum = 0u; cnt = 0u; mine = 0u;
#pragma unroll
        for (unsigned j = 0; j < 16; ++j) { const unsigned c = xb_ld(&bar[XB_XCNT(j)]); sum += c; cnt += (c > 0u) ? 1u : 0u; mine = (j == x) ? c : mine; }
        if (sum == G) break;
        __builtin_amdgcn_s_sleep(1);
        if ((++sp & 255u) == 0u) { if (xb_ld(&bar[XB_TMO])) break; if (sp > XB_SPIN_CAP) { atomicAdd(&bar[XB_TMO], 1u); break; } }
    }
    nloc = mine > 0u ? mine : 1u; nx = cnt > 0u ? cnt : 1u;
}
__device__ __forceinline__ void xcd_barrier(const XcdBarrier& b) {
    asm volatile("s_waitcnt vmcnt(0)" ::: "memory");
    __syncthreads();
    if (threadIdx.x == 0) {
        unsigned* bar = b.bar;
        __builtin_amdgcn_s_waitcnt(0);
        unsigned nloc = b.st[0], nx = b.st[1];
        if (nloc == 0u) { xcd_barrier_complete(bar, b.x, nloc, nx); b.st[0] = nloc; b.st[1] = nx; }
        const unsigned old = xb_add(&bar[XB_XSUB(b.x)], 1u);
        const unsigned gen = old / nloc;
        if (old + 1u == (gen + 1u) * nloc) {
            __builtin_amdgcn_fence(__ATOMIC_RELEASE, "agent");
            asm volatile("s_waitcnt vmcnt(0)" ::: "memory");
            const unsigned og = xb_add(&bar[XB_TOP], 1u);
            const unsigned tg = og / nx;
            if (og + 1u == (tg + 1u) * nx) xb_add(&bar[XB_TOPGEN], 1u);
            else XB_SPIN(xb_ld(&bar[XB_TOPGEN]) == tg, bar);
            __builtin_amdgcn_fence(__ATOMIC_ACQUIRE, "agent");
            xb_add(&bar[XB_XGEN(b.x)], 1u);
            asm volatile("s_waitcnt vmcnt(0)" ::: "memory");
        } else {
            XB_SPIN(xb_ld(&bar[XB_XGEN(b.x)]) == gen, bar);
            __builtin_amdgcn_fence(__ATOMIC_ACQUIRE, "agent");
            asm volatile("s_waitcnt vmcnt(0)" ::: "memory");
        }
    }
    __syncthreads();
}

__device__ __forceinline__ void p0_item_load(const float* W, int N, int item, int lane, float (&wv)[32]) {
    const int nblk = N / 32, kb = item / nblk, nb = item % nblk, k0 = 64 * kb, n0 = 32 * nb;
#pragma unroll
    for (int i = 0; i < 32; ++i) wv[i] = __builtin_nontemporal_load(W + (size_t)(k0 + 2 * i + (lane >> 5)) * N + n0 + (lane & 31));
}
template <bool WTHRU = false> __device__ __forceinline__ void p0_item_finish(float (&wv)[32], int K, int N, const float* gk, bf16_t* WT, int row_off, int kind, LAS float* scr, int item, int lane) {
    const int nblk = N / 32, kb = item / nblk, nb = item % nblk, k0 = 64 * kb, n0 = 32 * nb;
    if (gk) {
#pragma unroll
        for (int i = 0; i < 32; ++i) wv[i] *= gk[k0 + 2 * i + (lane >> 5)]; }
#pragma unroll
    for (int i = 0; i < 32; ++i) scr[(2 * i + (lane >> 5)) * 33 + (lane & 31)] = wv[i];
    LDS_WAIT(); asm volatile("" ::: "memory");
    const int c = lane & 7;
#pragma unroll
    for (int j = 0; j < 4; ++j) { const int n = (lane >> 3) + 8 * j; const LAS float* s = scr + (8 * c) * 33 + n;
        u32x4 o; o.x = cvt_pk_bf16(s[0 * 33], s[1 * 33]); o.y = cvt_pk_bf16(s[2 * 33], s[3 * 33]); o.z = cvt_pk_bf16(s[4 * 33], s[5 * 33]); o.w = cvt_pk_bf16(s[6 * 33], s[7 * 33]);
        if constexpr (WTHRU) st16_wt(mk_rsrc(WT, 0x7fffffffu), (unsigned)(((size_t)(row_off + dest_row(kind, n0 + n)) * K + k0 + 8 * c) * 2), o);
        else *(u32x4*)(WT + (size_t)(row_off + dest_row(kind, n0 + n)) * K + k0 + 8 * c) = o; }
    LDS_WAIT(); asm volatile("" ::: "memory");
}
template <bool WTHRU = false> __device__ __forceinline__ void p0_transpose_item(const float* W, int K, int N, const float* gk, bf16_t* WT, int row_off, int kind, LAS float* scr, int item, int lane) {
    float wv[32]; p0_item_load(W, N, item, lane, wv); p0_item_finish<WTHRU>(wv, K, N, gk, WT, row_off, kind, scr, item, lane);
}

struct SchedG1 : pg8::StaticOrder {
    const float* rs0; const float* conv_w; const float* conv_b; LAS unsigned char* tab;
    __device__ __forceinline__ void a_ready(const Unit& u) const {
        const int lane = threadIdx.x & 63, wave = __builtin_amdgcn_readfirstlane(threadIdx.x >> 6);
        LAS unsigned char* t = tab + (u.slot & 1) * 2048;
        if (wave == 0) __builtin_amdgcn_global_load_lds((const unsigned*)(rs0 + (size_t)u.pm * 256 + lane * 4), (LAS unsigned*)t, 16, 0, 0);
        else if (wave == 1) { const int a = lane >> 4, c4 = (lane & 15) * 4;
            const float* src = (a < 3 ? conv_w + (size_t)a * E : conv_b) + u.pn * 64 + c4;
            __builtin_amdgcn_global_load_lds((const unsigned*)src, (LAS unsigned*)(t + 1024), 16, 0, 0); }
    }
};
struct SchedG2 {
    int c; unsigned* cnt2;
    __device__ __forceinline__ bool next(int i, Unit& u) const { u.slot = i & 1; if (i == 0) { prompt_unit(c, 4, u); return true; } if (i == 1 && c < 8) { u.pm = 64 + (c >> 2); u.pn = c & 3; return true; } return false; }
    __device__ __forceinline__ void a_ready(const Unit&) const {}
    __device__ __forceinline__ void done(const Unit& u, int) const {
        asm volatile("s_waitcnt vmcnt(0)" ::: "memory"); __builtin_amdgcn_s_barrier();
        if (threadIdx.x == 0) __hip_atomic_fetch_add(cnt2 + 64 * u.pm, 1u, __ATOMIC_RELAXED, __HIP_MEMORY_SCOPE_AGENT); }
};
struct SchedG3 {
    int c; const unsigned* cnt2; const float* ss1; LAS unsigned char* rsb;
    __device__ __forceinline__ bool next(int i, Unit& u) const {
        const int x = c & 7, j = (c >> 3) & 7, q = c >> 6;
        if (c < 8) { if (i >= 2) return false; u.pm = 8 * c; u.pn = i; u.slot = i ? 2 : 0; return true; }
        const bool smp = (j == 0 && q == 3) || (j == 1 && q <= 2), shed = j == 0 && (q == 1 || q == 2);
        if (smp) {
            if (i > 4) return false;
            if (i == 2) { const int sidx = j == 0 ? x : 8 + 8 * q + x; u.pm = 64 + (sidx >> 4); u.pn = sidx & 15; u.slot = 1; return true; }
            const int o = i < 2 ? i : i - 1; u.pm = 8 * x + j; u.pn = 4 * q + o; u.slot = i ? 2 : 0; return true;
        }
        if (i < 4) { u.pm = 8 * x + j; u.pn = 4 * q + i; u.slot = i ? 2 : 0; return true; }
        if (i == 4 && shed) { u.pm = 8 * x; u.pn = 1 + q; u.slot = 2; return true; }
        return false;
    }
    __device__ __forceinline__ int panel_units() const { const int j = (c >> 3) & 7, q = c >> 6; return c < 8 ? 2 : (j == 0 && (q == 1 || q == 2)) ? 5 : 4; }
    __device__ __forceinline__ bool has_sample() const { const int j = (c >> 3) & 7, q = c >> 6; return c >= 8 && ((j == 0 && q == 3) || (j == 1 && q <= 2)); }
    __device__ __forceinline__ void a_ready(const Unit& u) const {
        if (u.slot & 2) return;
        wait_count(cnt2 + 64 * u.pm, 4u);
        const int t = threadIdx.x;
        if (t < 256) { const f32x4* sp = (const f32x4*)(ss1 + ((size_t)u.pm * 256 + t) * 16);
            const f32x4 st = (sp[0] + sp[1]) + (sp[2] + sp[3]);
            *(LAS float*)(rsb + (u.slot & 1) * 1024 + t * 4) = rsqrtf(((st[0] + st[1]) + (st[2] + st[3])) * (1.0f / D) + EPS); }
    }
    __device__ __forceinline__ void done(const Unit&, int) const {}
};
struct SchedOne {
    int pm, pn; bool has;
    __device__ __forceinline__ bool next(int i, Unit& u) const { u.slot = 0; if (has && i == 0) { u.pm = pm; u.pn = pn; return true; } return false; }
    __device__ __forceinline__ void a_ready(const Unit&) const {}
    __device__ __forceinline__ void done(const Unit&, int) const {}
};
struct SchedG5 {
    int c;
    __device__ __forceinline__ bool next(int i, Unit& u) const { u.slot = 0; if (i == 0) { prompt_unit(c, 4, u); return true; } return false; }
    __device__ __forceinline__ void a_ready(const Unit&) const {}
    __device__ __forceinline__ void done(const Unit&, int) const {}
};

template <int W, int NT> __device__ __forceinline__ void pool_slide(const float* hist, bool zero_hist, const float* cur, const bf16_t* sz, bf16_t* y1) {
    f32x4 x[W - 1 + NT]; u32x2 zw[NT];
#pragma unroll
    for (int i = 0; i < W - 1; ++i) x[i] = zero_hist ? (f32x4){0.f, 0.f, 0.f, 0.f} : *(const f32x4*)(hist + (size_t)(PH - (W - 1) + i) * E);
#pragma unroll
    for (int t = 0; t < NT; ++t) { x[W - 1 + t] = *(const f32x4*)(cur + (size_t)t * E); zw[t] = *(const u32x2*)(sz + (size_t)t * E); }
    f32x4 s = (f32x4){0.f, 0.f, 0.f, 0.f};
#pragma unroll
    for (int i = 0; i < W - 1; ++i) s += x[i];
#pragma unroll
    for (int t = 0; t < NT; ++t) {
        s += x[W - 1 + t];
        const float inv = 1.0f / (float)((zero_hist && t + 1 < W) ? t + 1 : W);
        const f32x4 c = x[W - 1 + t];
        u32x2 o; o.x = cvt_pk_bf16((s[0] * inv - c[0]) * bflo(zw[t].x), (s[1] * inv - c[1]) * bfhi(zw[t].x)); o.y = cvt_pk_bf16((s[2] * inv - c[2]) * bflo(zw[t].y), (s[3] * inv - c[3]) * bfhi(zw[t].y));
        *(u32x2*)(y1 + (size_t)t * E) = o;
        s -= x[t];
    }
}
template <int W> __device__ __forceinline__ void pool_slide_smp(const float* hist, const float* cur, const bf16_t* sz, rsrc_t y1r, unsigned y1off) {
    f32x4 xa[W - 1 + DSEQ], xb[W - 1 + DSEQ]; u32x4 zw[DSEQ];
#pragma unroll
    for (int i = 0; i < W - 1; ++i) { const float* hp = hist + (size_t)(PH - (W - 1) + i) * DB * E; xa[i] = *(const f32x4*)hp; xb[i] = *(const f32x4*)(hp + 4); }
#pragma unroll
    for (int t = 0; t < DSEQ; ++t) { xa[W - 1 + t] = *(const f32x4*)(cur + (size_t)t * E); xb[W - 1 + t] = *(const f32x4*)(cur + (size_t)t * E + 4); zw[t] = *(const u32x4*)(sz + (size_t)t * E); }
    f32x4 sa = (f32x4){0.f, 0.f, 0.f, 0.f}, sb = (f32x4){0.f, 0.f, 0.f, 0.f};
#pragma unroll
    for (int i = 0; i < W - 1; ++i) { sa += xa[i]; sb += xb[i]; }
    constexpr float inv = 1.0f / (float)W;
#pragma unroll
    for (int t = 0; t < DSEQ; ++t) {
        sa += xa[W - 1 + t]; sb += xb[W - 1 + t];
        const f32x4 ca = xa[W - 1 + t], cb = xb[W - 1 + t];
        u32x4 o;
        o.x = cvt_pk_bf16((sa[0] * inv - ca[0]) * bflo(zw[t].x), (sa[1] * inv - ca[1]) * bfhi(zw[t].x)); o.y = cvt_pk_bf16((sa[2] * inv - ca[2]) * bflo(zw[t].y), (sa[3] * inv - ca[3]) * bfhi(zw[t].y));
        o.z = cvt_pk_bf16((sb[0] * inv - cb[0]) * bflo(zw[t].z), (sb[1] * inv - cb[1]) * bfhi(zw[t].z)); o.w = cvt_pk_bf16((sb[2] * inv - cb[2]) * bflo(zw[t].w), (sb[3] * inv - cb[3]) * bfhi(zw[t].w));
        st16_wt(y1r, y1off + (unsigned)(t * E * 2), o);
        sa -= xa[t]; sb -= xb[t];
    }
}
template <int W> __device__ __forceinline__ void pool_fix_run(int r, int e, const float* HV, const float* PV, const bf16_t* PSZ, bf16_t* Y1) {
    const bool first = (r & 15) == 0;
    pool_slide<W, 16>(HV + ((size_t)(first ? r : r - 1) * PH) * E + e, first, PV + ((size_t)r * 16) * E + e, PSZ + ((size_t)r * 16) * E + e, Y1 + ((size_t)r * 128) * E + e);
}

struct Args { const float* in[14]; float* out; unsigned char* ws; };

__global__ void __launch_bounds__(512, 2) fwd_kernel(Args a) {
    extern __shared__ __attribute__((aligned(16))) unsigned char lds_raw[];
    LAS unsigned char* lds = (LAS unsigned char*)lds_raw;
    const int G = gridDim.x, bx = blockIdx.x;
    const int vcu = (G % 8 == 0) ? (bx % 8) * (G / 8) + bx / 8 : bx;
#define PHASE_IDS() int tid = threadIdx.x; asm volatile("" : "+v"(tid)); const int lane = tid & 63, wave = __builtin_amdgcn_readfirstlane(tid >> 6); \
    const int gw = vcu * 8 + wave, NGW = G * 8, gtid = vcu * 512 + tid, NGT = G * 512; (void)lane; (void)gw; (void)NGW; (void)gtid; (void)NGT
    const float* x_p = a.in[0]; const float* x_s = a.in[1]; const float* st_conv = a.in[2]; const float* st_pool = a.in[3];
    const float* norm_g = a.in[4]; const float* fin_g = a.in[5]; const float* w_in1 = a.in[6]; const float* conv_w = a.in[7]; const float* conv_b = a.in[8];
    const float* w_out1 = a.in[9]; const float* w_in2 = a.in[10]; const float* w_grp = a.in[11]; const float* p_scale = a.in[12]; const float* w_out2 = a.in[13];
    float* out = a.out; unsigned char* ws = a.ws;
    bf16_t* W1T = (bf16_t*)(ws + WS_W1T); bf16_t* W2T = (bf16_t*)(ws + WS_W2T); bf16_t* W3T = (bf16_t*)(ws + WS_W3T); bf16_t* W4T = (bf16_t*)(ws + WS_W4T); bf16_t* W5T = (bf16_t*)(ws + WS_W5T);
    bf16_t* WUB = (bf16_t*)(ws + WS_WUB); bf16_t* W3U = (bf16_t*)(ws + WS_W3U); bf16_t* SPB = (bf16_t*)(ws + WS_SPB);
    bf16_t* XB = (bf16_t*)(ws + WS_XB); bf16_t* BB = (bf16_t*)(ws + WS_B);
    float* HCV = (float*)(ws + WS_HCV); float* PGB = (float*)(ws + WS_PGB); float* PCV = (float*)(ws + WS_PCV);
    float* HV = (float*)(ws + WS_HV); float* PV = (float*)(ws + WS_PV); bf16_t* PSZ = (bf16_t*)(ws + WS_PSZ); float* SV = (float*)(ws + WS_SV); bf16_t* SSZ = (bf16_t*)(ws + WS_SSZ);
    float* HP = (float*)(ws + WS_HP); float* SLAB = (float*)(ws + WS_SLAB);
    float* rs0 = (float*)(ws + WS_RS0); float* ss1 = (float*)(ws + WS_SS1);
    volatile LAS unsigned* bst = (volatile LAS unsigned*)(lds + 131072 + 64);
    if (threadIdx.x < 2) bst[threadIdx.x] = 0u;
    __syncthreads();
    const XcdBarrier xbar = xcd_barrier_post((unsigned*)(ws + WS_CTL), bst);
#define GRID_SYNC() xcd_barrier(xbar)
    unsigned* cnt2 = (unsigned*)(ws + WS_CTL) + 4096; unsigned* cnt5 = cnt2 + 64 * 128;
#define CVT_HALF_ROW(src, dst, sc) do { f32x4 _v[4]; _Pragma("unroll") for (int _j = 0; _j < 4; ++_j) _v[_j] = __builtin_nontemporal_load((const f32x4*)((src) + (64 * _j + lane) * 4)); \
        _Pragma("unroll") for (int _j = 0; _j < 4; ++_j) { u32x2 _w; _w.x = cvt_pk_bf16(_v[_j][0] * (sc), _v[_j][1] * (sc)); _w.y = cvt_pk_bf16(_v[_j][2] * (sc), _v[_j][3] * (sc)); *(u32x2*)((dst) + (64 * _j + lane) * 4) = _w; } } while (0)

    {
        PHASE_IDS();
        LAS float* scr = (LAS float*)(lds + wave * 16384);
        constexpr int I1 = (D / 64) * (N1 / 32);
        static_assert(I1 == 2 * 256 * 8, "two weight items per wave on a 256-workgroup grid");
        float wa[32], wb[32];
        p0_item_load(w_in1, N1, gw, lane, wa); p0_item_load(w_in1, N1, gw + NGW, lane, wb);
        int row0 = gw * 2;
        f32x4 v[2][4], vn[2][4];
        { const float* xr = row0 < MP ? x_p + (size_t)row0 * D : x_s + (size_t)(row0 - MP) * D;
#pragma unroll
          for (int q = 0; q < 2; ++q)
#pragma unroll
            for (int j = 0; j < 4; ++j) v[q][j] = __builtin_nontemporal_load((const f32x4*)(xr + (size_t)q * D + (64 * j + lane) * 4)); }
        p0_item_finish(wa, D, N1, norm_g, W1T, 0, 0, scr, gw, lane);
        p0_item_finish(wb, D, N1, norm_g, W1T, 0, 0, scr, gw + NGW, lane);
        for (; row0 < M; row0 += NGW * 2) {
            const int rn = row0 + NGW * 2;
            if (rn < M) { const float* xr = rn < MP ? x_p + (size_t)rn * D : x_s + (size_t)(rn - MP) * D;
#pragma unroll
                for (int q = 0; q < 2; ++q)
#pragma unroll
                    for (int j = 0; j < 4; ++j) vn[q][j] = __builtin_nontemporal_load((const f32x4*)(xr + (size_t)q * D + (64 * j + lane) * 4)); }
            float ss[2];
#pragma unroll
            for (int q = 0; q < 2; ++q) { float a = 0.f;
#pragma unroll
                for (int j = 0; j < 4; ++j) a += (v[q][j][0] * v[q][j][0] + v[q][j][1] * v[q][j][1]) + (v[q][j][2] * v[q][j][2] + v[q][j][3] * v[q][j][3]);
                ss[q] = wave_sum(a); }
#pragma unroll
            for (int q = 0; q < 2; ++q)
#pragma unroll
                for (int j = 0; j < 4; ++j) { u32x2 w; w.x = cvt_pk_bf16(v[q][j][0], v[q][j][1]); w.y = cvt_pk_bf16(v[q][j][2], v[q][j][3]); *(u32x2*)(XB + (size_t)(row0 + q) * D + (64 * j + lane) * 4) = w; }
            if (lane < 2) rs0[row0 + lane] = rsqrtf((lane == 0 ? ss[0] : ss[1]) * (1.0f / D) + EPS);
#pragma unroll
            for (int q = 0; q < 2; ++q)
#pragma unroll
                for (int j = 0; j < 4; ++j) v[q][j] = vn[q][j];
        }
    }
    GRID_SYNC();

    {
        pg8::Gemm g{XB, W1T, M, N1, D, D, 0, 0, D, 0, 0}; SchedG1 S; S.init(M, N1, G, bx); S.rs0 = rs0; S.conv_w = conv_w; S.conv_b = conv_b; S.tab = lds + pg8::STAGE_BYTES + 1024;
        Epi1 Ep{lds + pg8::STAGE_BYTES + 1024, BB, HCV, PGB, PCV, st_conv, out};
        pg8::gemm_phase<Epi1, SchedG1, true, true, 1>(lds, g, S, Ep);
    }
    unsigned* cntW = cnt5 + 64 * 80;
    if (bx >= 64 && bx < 96) {
        const int idx = bx - 64;
        wait_count(cntW, (unsigned)(G - 96));
        pg8::Gemm g{W4T, WUB, E, D, GC, GC, 0, 0, E, 1, GC}; SchedOne S{idx >> 2, idx & 3, true};
        EpiWp Ep{W3T};
        pg8::gemm_phase<EpiWp, SchedOne, true, true, 0>(lds, g, S, Ep);
    } else if (bx >= 96) {
        PHASE_IDS();
        LAS float* scr = (LAS float*)(lds + wave * 16384);
        constexpr int IT = (D / 64) * (E / 32);
        const int tw = (bx - 96) * 8 + wave, NTW = (G - 96) * 8;
        { constexpr int I4 = (GC / 64) * (GC / 32);
          for (int it = tw; it < 4 * I4; it += NTW) { const int g = it / I4; p0_transpose_item<true>(w_grp + (size_t)g * GC * GC, GC, GC, nullptr, W4T, g * GC, 2, scr, it % I4, lane); }
          const rsrc_t ur = mk_rsrc(WUB, (unsigned)((size_t)D * E * 2));
          for (int it = tw; it < D * 2; it += NTW) { const int k = it >> 1, hf = it & 1; const float sc = norm_g[D + k]; const float* src = w_in2 + (size_t)k * N3 + hf * 1024;
              f32x4 va[2], vb[2];
#pragma unroll
              for (int j = 0; j < 2; ++j) { va[j] = __builtin_nontemporal_load((const f32x4*)(src + (64 * j + lane) * 8)); vb[j] = __builtin_nontemporal_load((const f32x4*)(src + (64 * j + lane) * 8 + 4)); }
#pragma unroll
              for (int j = 0; j < 2; ++j) { u32x4 o; o.x = cvt_pk_bf16(va[j][0] * sc, va[j][1] * sc); o.y = cvt_pk_bf16(va[j][2] * sc, va[j][3] * sc); o.z = cvt_pk_bf16(vb[j][0] * sc, vb[j][1] * sc); o.w = cvt_pk_bf16(vb[j][2] * sc, vb[j][3] * sc);
                  st16_wt(ur, (unsigned)(((size_t)k * E + hf * 1024 + (64 * j + lane) * 8) * 2), o); } }
          asm volatile("s_waitcnt vmcnt(0)" ::: "memory"); __syncthreads();
          if (tid == 0) __hip_atomic_fetch_add(cntW, 1u, __ATOMIC_RELAXED, __HIP_MEMORY_SCOPE_AGENT); }
        for (int it = tw; it < 4 * IT; it += NTW) {
            const int r = it & (IT - 1), kb = r >> 6, nb = r & 63;
            if (it >= 3 * IT) p0_transpose_item(w_out2, E, D, p_scale, W5T, 0, 2, scr, r, lane);
            else if (it < IT) p0_transpose_item(w_out1, E, D, nullptr, W2T, 0, 2, scr, r, lane);
            else if (it < 2 * IT) p0_transpose_item(w_in2, D, N3, norm_g + D, W3T, 0, 1, scr, kb * (N3 / 32) + 64 + nb, lane);
            else p0_transpose_item(w_in2, D, N3, norm_g + D, W3U, 0, 2, scr, kb * (N3 / 32) + nb, lane);
        }
        for (int it = tw; it < 2048 * 2; it += NTW) {
            const int row = it >> 1, hf = it & 1, drow = row < DB * PH ? (row % PH) * DB + row / PH : row;
            if (row < DB * PH) CVT_HALF_ROW(st_pool + (size_t)row * E + hf * 1024, SPB + (size_t)drow * E + hf * 1024, 1.0f);
            else {
#pragma unroll
                for (int j = 0; j < 4; ++j) *(u32x2*)(SPB + (size_t)row * E + hf * 1024 + (64 * j + lane) * 4) = (u32x2){0u, 0u}; }
        }
    }
    GRID_SYNC();
    {
        PHASE_IDS(); (void)gw;
        Unit u; prompt_unit(bx, 4, u);
        const int c = tid & 255, e = c * 8, run = 2 * u.pm + (tid >> 8);
        float w0[8], w1[8], w2[8], bb[8];
#pragma unroll
        for (int j = 0; j < 8; ++j) { w0[j] = conv_w[e + j]; w1[j] = conv_w[E + e + j]; w2[j] = conv_w[2 * E + e + j]; bb[j] = conv_b[e + j]; }
        float h0[8], h1[8], g0[8], g1[8], c0[8], c1[8];
        if (run & 15) { const float* h = HCV + ((size_t)(run - 1) * 2) * E + e;
#pragma unroll
            for (int j = 0; j < 8; ++j) { h0[j] = h[j]; h1[j] = h[E + j]; } }
        else {
#pragma unroll
            for (int j = 0; j < 8; ++j) { h0[j] = 0.f; h1[j] = 0.f; } }
        const float* pg = PGB + ((size_t)run * 2) * E + e; const float* pc = PCV + ((size_t)run * 2) * E + e;
#pragma unroll
        for (int j = 0; j < 8; ++j) { g0[j] = pg[j]; g1[j] = pg[E + j]; c0[j] = pc[j]; c1[j] = pc[E + j]; }
        float y0[8], y1[8];
#pragma unroll
        for (int j = 0; j < 8; ++j) { y0[j] = g0[j] * (bb[j] + w0[j] * h0[j] + w1[j] * h1[j] + w2[j] * c0[j]); y1[j] = g1[j] * (bb[j] + w0[j] * h1[j] + w1[j] * c0[j] + w2[j] * c1[j]); }
        *(u32x4*)(BB + ((size_t)run * 128) * E + e) = f32_to_bf8(y0); *(u32x4*)(BB + ((size_t)run * 128 + 1) * E + e) = f32_to_bf8(y1);
        asm volatile("s_waitcnt vmcnt(0)" ::: "memory"); __syncthreads();
    }
    {
        pg8::Gemm g{BB, W2T, M, D, E, E, 0, 0, E, 0, 0}; SchedG2 S{bx, cnt2};
        EpiRes<true> Ep{XB, ss1};
        pg8::gemm_phase<EpiRes<true>, SchedG2, true, true, 0>(lds, g, S, Ep);
    }
    const int jq = (bx >> 3) & 7;
    unsigned* cntG3 = cnt2 + 16384;
    unsigned* cntSV = cnt5 + 64 * 82; unsigned* cntHP = cnt5 + 64 * 83; unsigned* cntS2 = cnt5 + 64 * 84; unsigned* cntSL = cnt5 + 64 * 85;
    {
        pg8::Gemm g{XB, W3T, M, N3, D, D, 0, 0, D, 0, 0}; SchedG3 S{bx, cnt2, ss1, lds + pg8::STAGE_BYTES + 1024};
        Epi3 Ep{lds + pg8::STAGE_BYTES + 1024, BB, HV, PV, PSZ, SV, SSZ};
        pg8::gemm_phase<Epi3, SchedG3, true, true, 1>(lds, g, S, Ep);
        if (threadIdx.x == 0) { __hip_atomic_fetch_add(cntG3 + 64 * (8 * (bx & 7) + jq), (unsigned)S.panel_units(), __ATOMIC_RELAXED, __HIP_MEMORY_SCOPE_AGENT);
            if (S.has_sample()) __hip_atomic_fetch_add(cntSV, 1u, __ATOMIC_RELAXED, __HIP_MEMORY_SCOPE_AGENT); }
    }
    { const int i2 = (bx >> 6) * 8 + (bx & 7);
      const int hidx = (jq == 2 && i2 >= 16) ? i2 - 16 : bx < 8 ? 16 + bx : (jq == 3 && i2 < 6) ? 24 + i2 : -1;
      if (jq == 2 && i2 < 16) {
        const int pm = 64 + (i2 >> 3);
        wait_count(cnt2 + 64 * pm, 4u);
        pg8::Gemm g{XB, W3U, M, E, D, D, 0, 0, D, 0, 0}; SchedOne S{pm, i2 & 7, true};
        EpiU<false> Ep{ss1, out};
        pg8::gemm_phase<EpiU<false>, SchedOne, true, true, 0>(lds, g, S, Ep);
      } else if (hidx >= 0) {
        const int hpm = hidx < 16 ? hidx >> 1 : hidx < 24 ? 4 + ((hidx - 16) >> 1) : hidx < 28 ? 6 + ((hidx - 24) >> 1) : 7;
        const int hpn = (hidx < 16 ? 6 : hidx < 24 ? 4 : hidx < 28 ? 2 : 0) + (hidx & 1);
        pg8::Gemm g{SPB, W4T, 2048, E, GC, E, 1, GC, GC, 0, 0}; SchedOne S{hpm, hpn, true};
        EpiHist Ep{HP};
        pg8::gemm_phase<EpiHist, SchedOne, true, true, 0>(lds, g, S, Ep);
        if (threadIdx.x == 0) __hip_atomic_fetch_add(cntHP, 1u, __ATOMIC_RELAXED, __HIP_MEMORY_SCOPE_AGENT);
      }
    }
    if (false) {
    } else if (jq == 1 && bx >= 192) {
        if (threadIdx.x < 64) { const int t = threadIdx.x; unsigned sp = 0;
            for (;;) { const bool rdy = t >= NB || __hip_atomic_load(cnt2 + 64 * (8 * (t < NB ? t : 0) + 7), __ATOMIC_RELAXED, __HIP_MEMORY_SCOPE_AGENT) >= 4u;
                if (__all(rdy)) break; __builtin_amdgcn_s_sleep(2); if (++sp > (1u << 21)) break; }
            __builtin_amdgcn_fence(__ATOMIC_ACQUIRE, "agent"); asm volatile("s_waitcnt vmcnt(0)" ::: "memory"); }
        __syncthreads();
        pg8::Gemm g{XB, W3U, M, E, D, D, 0, 0, D, 0, 0}; SchedOne S{0, bx & 7, true};
        EpiU<true> Ep{ss1, out};
        pg8::gemm_phase<EpiU<true>, SchedOne, true, true, 2>(lds, g, S, Ep);
    }
    if (bx >= 152) {
        const int tt = (bx - 152) * 512 + threadIdx.x, NTT = (G - 152) * 512;
        for (int i = tt; i < DB * (PH - DSEQ) * (E / 4); i += NTT) {
            const int b = i / ((PH - DSEQ) * (E / 4)), rem = i % ((PH - DSEQ) * (E / 4)), r = rem / (E / 4), c4 = rem % (E / 4);
            *(f32x4*)(out + O_NPS + ((size_t)b * PH + r) * E + c4 * 4) = *(const f32x4*)(st_pool + ((size_t)b * PH + DSEQ + r) * E + c4 * 4);
        }
    }
    { PHASE_IDS(); (void)gw;
        Unit u; prompt_unit(bx, 4, u);
        if (tid < 64) { unsigned sp = 0;
            for (;;) { const bool rdy = lane >= 2 || (lane == 1 && jq == 0) || __hip_atomic_load(cntG3 + 64 * (u.pm - lane), __ATOMIC_RELAXED, __HIP_MEMORY_SCOPE_AGENT) >= 16u;
                if (__all(rdy)) break; __builtin_amdgcn_s_sleep(8); if (++sp > (1u << 19)) break; }
            __builtin_amdgcn_fence(__ATOMIC_ACQUIRE, "agent"); asm volatile("s_waitcnt vmcnt(0)" ::: "memory"); }
        __syncthreads();
        const int e = tid * 4, wsh = wave >> 1;
#pragma unroll 1
        for (int j = 0; j < 2; ++j) { const int r = 2 * u.pm + j;
            if (wsh == 0) pool_fix_run<2>(r, e, HV, PV, PSZ, BB); else if (wsh == 1) pool_fix_run<4>(r, e, HV, PV, PSZ, BB);
            else if (wsh == 2) pool_fix_run<8>(r, e, HV, PV, PSZ, BB); else pool_fix_run<16>(r, e, HV, PV, PSZ, BB); }
        asm volatile("s_waitcnt vmcnt(0)" ::: "memory"); __syncthreads();
    }
    {
        pg8::Gemm g{BB, W5T, M, D, E, E, 0, 0, E, 0, 0}; SchedG5 S{bx};
        EpiG5 Ep{XB, (float*)(ws + WS_SCV), cnt5, fin_g, out + O_Y, lds + pg8::STAGE_BYTES + 4096, lds};
        pg8::gemm_phase<EpiG5, SchedG5, true, true, 0>(lds, g, S, Ep);
    }
    if (jq == 4 || jq == 5) { PHASE_IDS(); (void)gw;
        const int sidx = (jq - 4) * 32 + (bx >> 6) * 8 + (bx & 7);
        if (tid < 64) { unsigned sp = 0;
            for (;;) { const bool rdy = lane >= 2 || __hip_atomic_load(lane == 0 ? cntSV : cntHP, __ATOMIC_RELAXED, __HIP_MEMORY_SCOPE_AGENT) >= (lane == 0 ? 32u : 30u);
                if (__all(rdy)) break; __builtin_amdgcn_s_sleep(16); if (++sp > (1u << 18)) break; }
            __builtin_amdgcn_fence(__ATOMIC_ACQUIRE, "agent"); asm volatile("s_waitcnt vmcnt(0)" ::: "memory"); }
        __syncthreads();
        const int b = sidx * 2 + (tid >> 8), c8 = tid & 255, es = c8 * 8, ws2 = c8 >> 6;
        const float* hp = HP + (size_t)b * E + es; const float* cp = SV + ((size_t)b * DSEQ) * E + es; const bf16_t* zp = SSZ + ((size_t)b * DSEQ) * E + es;
        const rsrc_t yr = mk_rsrc(BB + (size_t)MP * E, (unsigned)((size_t)MS * E * 2)); const unsigned yo = (unsigned)((((size_t)b * DSEQ) * E + es) * 2);
        if (ws2 == 0) pool_slide_smp<2>(hp, cp, zp, yr, yo); else if (ws2 == 1) pool_slide_smp<4>(hp, cp, zp, yr, yo);
        else if (ws2 == 2) pool_slide_smp<8>(hp, cp, zp, yr, yo); else pool_slide_smp<16>(hp, cp, zp, yr, yo);
        asm volatile("s_waitcnt vmcnt(0)" ::: "memory"); __syncthreads();
        if (tid < 16) { unsigned old = 0; if (tid == 0) old = __hip_atomic_fetch_add(cntS2, 1u, __ATOMIC_RELAXED, __HIP_MEMORY_SCOPE_AGENT);
            old = __builtin_amdgcn_readfirstlane(old);
            if (old == 63u) __hip_atomic_store(cnt5 + 64 * (90 + tid), 1u, __ATOMIC_RELAXED, __HIP_MEMORY_SCOPE_AGENT); }
    }
    { const int tl = jq >= 4 ? (jq - 4) * 32 + (bx >> 6) * 8 + (bx & 7) : -1;
      if (tl >= 0) { PHASE_IDS(); (void)gw;
        if (tid < 64) { unsigned sp = 0;
            for (;;) { const bool rdy = lane >= 3 || __hip_atomic_load(lane == 0 ? cnt5 + 64 * (90 + (bx & 15)) : cnt2 + 64 * (63 + lane), __ATOMIC_RELAXED, __HIP_MEMORY_SCOPE_AGENT) >= (lane == 0 ? 1u : 4u);
                if (__all(rdy)) break; __builtin_amdgcn_s_sleep(32); if (++sp > (1u << 18)) break; }
            __builtin_amdgcn_fence(__ATOMIC_ACQUIRE, "agent"); asm volatile("s_waitcnt vmcnt(0)" ::: "memory"); }
        __syncthreads();
        const int tm = tl >> 4, tn = tl & 15, fr = lane & 15, fq = lane >> 4;
        const bf16_t* Ap = BB + (size_t)(MP + 64 * tm + fr) * E + 256 * wave + 8 * fq;
        const bf16_t* Bp[4];
#pragma unroll
        for (int n = 0; n < 4; ++n) Bp[n] = W5T + (size_t)dest_row(2, 64 * tn + 16 * n + fr) * E + 256 * wave + 8 * fq;
        f32x4 acc[4][4];
#pragma unroll
        for (int m = 0; m < 4; ++m)
#pragma unroll
            for (int n = 0; n < 4; ++n) acc[m][n] = (f32x4){0.f, 0.f, 0.f, 0.f};
#pragma unroll
        for (int hf = 0; hf < 2; ++hf) {
            bf16x8 af[4][4], bfr[4][4];
#pragma unroll
            for (int kk = 0; kk < 4; ++kk) {
#pragma unroll
                for (int m = 0; m < 4; ++m) af[m][kk] = *(const bf16x8*)(Ap + (size_t)(16 * m) * E + 32 * (4 * hf + kk));
#pragma unroll
                for (int n = 0; n < 4; ++n) bfr[n][kk] = *(const bf16x8*)(Bp[n] + 32 * (4 * hf + kk));
            }
#pragma unroll
            for (int kk = 0; kk < 4; ++kk)
#pragma unroll
                for (int m = 0; m < 4; ++m)
#pragma unroll
                    for (int n = 0; n < 4; ++n) acc[m][n] = __builtin_amdgcn_mfma_f32_16x16x32_bf16(bfr[n][kk], af[m][kk], acc[m][n], 0, 0, 0);
        }
        LAS f32x4* red = (LAS f32x4*)lds;
#pragma unroll
        for (int m = 0; m < 4; ++m)
#pragma unroll
            for (int n = 0; n < 4; ++n) red[(wave * 16 + m * 4 + n) * 64 + lane] = acc[m][n];
        __syncthreads();
#pragma unroll
        for (int q = 0; q < 2; ++q) { const int blk = wave * 2 + q, m = blk >> 2, n = blk & 3;
            f32x4 sm = red[blk * 64 + lane];
#pragma unroll
            for (int w = 1; w < 8; ++w) sm += red[(w * 16 + blk) * 64 + lane];
            const int rs = 64 * tm + 16 * m + fr, col = 64 * tn + 16 * n + 4 * fq;
            const u32x2 xw = *(const u32x2*)(XB + (size_t)(MP + rs) * D + col);
            sm[0] += bflo(xw.x); sm[1] += bfhi(xw.x); sm[2] += bflo(xw.y); sm[3] += bfhi(xw.y);
            st16_wt(mk_rsrc(SLAB, (unsigned)((size_t)MS * D * 4)), (unsigned)(((size_t)rs * D + col) * 4), __builtin_bit_cast(u32x4, sm)); }
        asm volatile("s_waitcnt vmcnt(0)" ::: "memory"); __syncthreads();
        if (tid < 4) { unsigned old = 0; if (tid == 0) old = __hip_atomic_fetch_add(cntSL, 1u, __ATOMIC_RELAXED, __HIP_MEMORY_SCOPE_AGENT);
            old = __builtin_amdgcn_readfirstlane(old);
            if (old == 127u) __hip_atomic_store(cnt5 + 64 * (106 + tid), 1u, __ATOMIC_RELAXED, __HIP_MEMORY_SCOPE_AGENT); }
      } }
    if (jq == 3) { PHASE_IDS(); (void)gw;
        if (tid < 64) { unsigned sp = 0;
            while (__hip_atomic_load(cnt5 + 64 * (106 + (bx & 3)), __ATOMIC_RELAXED, __HIP_MEMORY_SCOPE_AGENT) < 1u) { __builtin_amdgcn_s_sleep(64); if (++sp > (1u << 17)) break; }
            __builtin_amdgcn_fence(__ATOMIC_ACQUIRE, "agent"); asm volatile("s_waitcnt vmcnt(0)" ::: "memory"); }
        __syncthreads();
        const int fidx = (bx >> 6) * 8 + (bx & 7);
        f32x4 ga[2], gb[2];
#pragma unroll
        for (int j = 0; j < 2; ++j) { ga[j] = *(const f32x4*)(fin_g + (64 * j + lane) * 8); gb[j] = *(const f32x4*)(fin_g + (64 * j + lane) * 8 + 4); }
#pragma unroll 1
        for (int rr = 0; rr < 2; ++rr) {
            const int row = MP + fidx * 16 + wave * 2 + rr;
            float v[2][8]; float a = 0.f;
#pragma unroll
            for (int j = 0; j < 2; ++j) { const float* sp = SLAB + (size_t)(row - MP) * D + (64 * j + lane) * 8;
                const f32x4 s0 = *(const f32x4*)sp, s1 = *(const f32x4*)(sp + 4);
#pragma unroll
                for (int e = 0; e < 4; ++e) { v[j][e] = s0[e]; v[j][4 + e] = s1[e]; }
#pragma unroll
                for (int e = 0; e < 8; ++e) a += v[j][e] * v[j][e]; }
            const float r = rsqrtf(wave_sum(a) * (1.0f / D) + EPS);
#pragma unroll
            for (int j = 0; j < 2; ++j) {
                const f32x4 o0 = (f32x4){v[j][0], v[j][1], v[j][2], v[j][3]} * r * ga[j], o1 = (f32x4){v[j][4], v[j][5], v[j][6], v[j][7]} * r * gb[j];
                float* yr = out + O_Y + (size_t)row * D;
                *(f32x4*)(yr + (64 * j + lane) * 8) = o0; *(f32x4*)(yr + (64 * j + lane) * 8 + 4) = o1; }
        }
    }
}

constexpr int LDS_BYTES = 147456;
extern "C" void kernel_launch(void* const* d_in, const int* in_sizes, int n_in, void* d_out, int out_size, void* d_ws, size_t ws_size, hipStream_t stream) {
    static int grid_blocks = 0;
    if (grid_blocks == 0) {
        if (n_in != 14 || ws_size < WS_END) { fprintf(stderr, "kernel_launch: unexpected problem (n_in %d, ws %zu)\n", n_in, ws_size); grid_blocks = -1; return; }
        int dev = 0, cus = 0, per_cu = 0;
        (void)hipGetDevice(&dev);
        (void)hipDeviceGetAttribute(&cus, hipDeviceAttributeMultiprocessorCount, dev);
        if (hipFuncSetAttribute((const void*)fwd_kernel, hipFuncAttributeMaxDynamicSharedMemorySize, LDS_BYTES) != hipSuccess) { fprintf(stderr, "kernel_launch: hipFuncSetAttribute failed\n"); grid_blocks = -1; return; }
        if (hipOccupancyMaxActiveBlocksPerMultiprocessor(&per_cu, (const void*)fwd_kernel, 512, LDS_BYTES) != hipSuccess || per_cu < 1) { fprintf(stderr, "kernel_launch: occupancy query failed or reports %d workgroups per CU; nothing launched\n", per_cu); (void)hipGetLastError(); grid_blocks = -1; return; }
        grid_blocks = cus * 1;
        if (grid_blocks != 256) { fprintf(stderr, "kernel_launch: built for a 256-CU device (static schedules), found %d CUs\n", cus); grid_blocks = -1; return; }
        fprintf(stderr, "kernel_launch: %d CUs, occupancy %d/CU, grid %d\n", cus, per_cu, grid_blocks);
    }
    if (grid_blocks < 0) return;
    (void)hipMemsetAsync((char*)d_ws + WS_CTL, 0, 262144, stream);
    Args a{};
    for (int i = 0; i < 14; ++i) a.in[i] = (const float*)d_in[i];
    a.out = (float*)d_out; a.ws = (unsigned char*)d_ws;
    void* args[] = {&a};
    hipError_t e = hipLaunchCooperativeKernel((const void*)fwd_kernel, dim3(grid_blocks), dim3(512), args, LDS_BYTES, stream);
    if (e != hipSuccess) fprintf(stderr, "cooperative launch failed: %s (grid %d)\n", hipGetErrorString(e), grid_blocks);
}
```

```cpp
#include <hip/hip_runtime.h>
#include <cstdio>
#include <cstdint>

#define LAS __attribute__((address_space(3)))
#define GAS __attribute__((address_space(1)))
typedef unsigned short bf16_t;
typedef short bf16x8 __attribute__((ext_vector_type(8)));
typedef float f32x4 __attribute__((ext_vector_type(4)));
typedef unsigned u32x4 __attribute__((ext_vector_type(4)));
typedef unsigned u32x2 __attribute__((ext_vector_type(2)));

constexpr int D = 1024, E = 2048, NB = 8, SEQ = 2048, DB = 128, DSEQ = 4;
constexpr int MP = NB * SEQ, MS = DB * DSEQ, M = MP + MS;
constexpr int N1 = 4 * E, N3 = 2 * E, GC = 512, PH = 15;
constexpr float EPS = 1e-6f;
constexpr size_t O_Y = 0, O_NCP = (size_t)M * D, O_NCS = O_NCP + (size_t)NB * 2 * E, O_NPP = O_NCS + (size_t)DB * 2 * E, O_NPS = O_NPP + (size_t)NB * PH * E;
constexpr size_t MiB = 1u << 20;
constexpr size_t WS_CTL = 0, WS_W4T = 1 * MiB, WS_W5T = 3 * MiB, WS_RS0 = 7 * MiB, WS_W3T = 8 * MiB, WS_XB = 16 * MiB, WS_SS1 = 49 * MiB;
constexpr size_t WS_HV = 53 * MiB, WS_PV = 69 * MiB;
constexpr size_t WS_B = 86 * MiB;
constexpr size_t WS_W1T = 152 * MiB;
constexpr size_t WS_HCV = 168 * MiB, WS_PGB = 171 * MiB, WS_PCV = 174 * MiB, WS_SCV = 177 * MiB, WS_SGB = 181 * MiB;
constexpr size_t WS_WUB = 185 * MiB;
constexpr size_t WS_W3U = 189 * MiB;
constexpr size_t WS_SPB = 193 * MiB;
constexpr size_t WS_HP = 201 * MiB;
constexpr size_t WS_SLAB = 217 * MiB;
constexpr size_t WS_PSZ = 233 * MiB;
constexpr size_t WS_SV = 242 * MiB, WS_SSZ = 246 * MiB;
constexpr size_t WS_W2T = 248 * MiB;
constexpr size_t WS_END = 252 * MiB;
constexpr int NRUN = MP / 128;
static_assert(WS_PV + (size_t)NRUN * 16 * E * 4 <= WS_B && WS_HV + (size_t)NRUN * PH * E * 4 <= WS_PV && WS_XB + (size_t)M * D * 2 <= WS_SS1 && WS_B + (size_t)M * E * 2 <= WS_W1T, "ws map 1");
static_assert(WS_SGB + (size_t)MS * E * 4 <= WS_WUB && WS_HP + (size_t)2048 * E * 4 <= WS_SLAB && WS_SLAB + (size_t)8 * MS * D * 4 <= WS_PSZ && WS_PSZ + (size_t)NRUN * 16 * E * 2 <= WS_SV && WS_SSZ + (size_t)MS * E * 2 <= WS_W2T, "ws map 2");

namespace pg8 {
constexpr int BM = 256, BK = 64, HALF = 128, HTB = HALF * BK * 2, STAGE_BYTES = 8 * HTB, NXCD = 8, WGM = 8;
__host__ __device__ __forceinline__ int lds_byte(int r, int c) { const int st = (r >> 4) * 2 + (c >> 5), rr = r & 15, cc = c & 31, ob = rr * 64 + cc * 2; return st * 1024 + (ob ^ (((ob >> 9) & 1) << 5)); }
__host__ __device__ __forceinline__ void stage_rc(int b, int& R, int& C) { const int st = b / 1024, sb = b % 1024, swz = sb ^ (((sb >> 9) & 1) << 5); R = (st >> 1) * 16 + swz / 64; C = (st & 1) * 32 + (swz % 64) / 2; }

struct Unit { int pm, pn, slot; };
struct Gemm { const bf16_t* A; const bf16_t* Bt; int M, N, K, lda, agshift, agstride, ldb, bgshift, bgstride; };

struct StaticOrder {
    int nM, nN, nwg, G, c;
    __device__ void init(int M_, int N_, int G_, int c_) { nM = M_ / BM; nN = N_ / BM; nwg = nM * nN; G = G_; c = c_; }
    __device__ bool next(int i, Unit& u) const {
        const long L = (long)i * G + c; if (L >= nwg) return false;
        int wgid = (int)L; { const int q = nwg / NXCD, r = nwg % NXCD, xcd = wgid % NXCD, off = wgid / NXCD; wgid = (xcd < r ? xcd * (q + 1) : r * (q + 1) + (xcd - r) * q) + off; }
        const int nig = WGM * nN, gid = wgid / nig, fm = gid * WGM, gsz = (nM - fm) < WGM ? (nM - fm) : WGM;
        u.pm = fm + ((wgid % nig) % gsz); u.pn = (wgid % nig) / gsz; u.slot = i & 1; return true;
    }
    __device__ __forceinline__ void a_ready(const Unit&) const {}
    __device__ __forceinline__ void done(const Unit&, int) const {}
};

__device__ __forceinline__ unsigned cvt_pk_bf16(float lo, float hi) { unsigned r; asm("v_cvt_pk_bf16_f32 %0, %1, %2" : "=v"(r) : "v"(lo), "v"(hi)); return r; }

template <class Epi, class Sched, bool ALIGN_EPI, bool SP2, int ROWPERM>
__device__ __forceinline__ void gemm_phase(LAS unsigned char* lds, const Gemm g, const Sched& S, const Epi& E) {
    int tid = threadIdx.x; asm volatile("" : "+v"(tid));
    const int wid = __builtin_amdgcn_readfirstlane(tid >> 6), lane = tid & 63, wr = wid >> 2, wc = wid & 3, fr = lane & 15, fq = lane >> 4;
    const int K = g.K, nt = K / BK, lda = g.lda;
    unsigned voffA[2], voffB[2];
#pragma unroll
    for (int i = 0; i < 2; ++i) { int R, C; stage_rc(tid * 16 + i * 8192, R, C); const int Ra = ROWPERM == 2 ? ((R >> 4) * 2048 + 2032 + (R & 15)) : ROWPERM == 1 ? (128 * ((R >> 6) & 1) + 8 * (R & 15) + ((R >> 4) & 3)) : R;
        voffA[i] = (unsigned)(Ra * lda + C) * 2u; voffB[i] = (unsigned)(R * g.ldb + C) * 2u; }
    const size_t kstep = (size_t)(BK * 2);
    const size_t tstepA = (size_t)BM * lda * 2, hstepA = ROWPERM == 2 ? (size_t)0 : ROWPERM == 1 ? (size_t)4 * lda * 2 : (size_t)HALF * lda * 2, hstepB = (size_t)HALF * g.ldb * 2;
    const unsigned ldsw = (unsigned)wid * 1024u;
    const int aoff = lds_byte(wr * 64 + fr, fq * 8), boff = lds_byte(wc * 32 + fr, fq * 8);
#define PG8_UA(u) ((const char*)g.A + (size_t)(u).pm * tstepA + (size_t)(((u).pn >> g.agshift) * g.agstride) * 2)
#define PG8_UB(u) ((const char*)g.Bt + (size_t)(u).pn * 2 * hstepB + (size_t)(((u).pm >> g.bgshift) * g.bgstride) * 2)
#define PG8_SA(b, h) (((b) * 2 + (h)) * HTB)
#define PG8_SB(b, h) ((4 + (b) * 2 + (h)) * HTB)
#define PG8_STAGE(bufoff, gbase, voff) do { _Pragma("unroll") for (int _i = 0; _i < 2; ++_i) \
        __builtin_amdgcn_global_load_lds((const unsigned*)((const char*)(gbase) + (voff)[_i]), (LAS unsigned*)(lds + (bufoff) + ldsw + _i * 8192), 16, 0, 0); } while (0)
#define PG8_LDA(dst, b, h) do { _Pragma("unroll") for (int m = 0; m < 4; ++m) _Pragma("unroll") for (int k = 0; k < 2; ++k) dst[m][k] = *(const LAS bf16x8*)(lds + PG8_SA(b, h) + aoff + m * 2048 + k * 1024); } while (0)
#define PG8_LDB(dst, b, h) do { _Pragma("unroll") for (int n = 0; n < 2; ++n) _Pragma("unroll") for (int k = 0; k < 2; ++k) dst[n][k] = *(const LAS bf16x8*)(lds + PG8_SB(b, h) + boff + n * 2048 + k * 1024); } while (0)
#define PG8_MMA(ai, bj, At, Bt) do { __builtin_amdgcn_s_setprio(1); _Pragma("unroll") for (int m = 0; m < 4; ++m) _Pragma("unroll") for (int n = 0; n < 2; ++n) _Pragma("unroll") for (int k = 0; k < 2; ++k) \
        acc[ai][bj][m][n] = __builtin_amdgcn_mfma_f32_16x16x32_bf16(Bt[n][k], At[m][k], acc[ai][bj][m][n], 0, 0, 0); __builtin_amdgcn_s_setprio(0); } while (0)
#define PG8_WAIT_V(n) asm volatile("s_waitcnt vmcnt(" #n ")" ::: "memory")
#define PG8_WAIT_L(n) asm volatile("s_waitcnt lgkmcnt(" #n ")" ::: "memory")
#define PG8_BAR __builtin_amdgcn_s_barrier()
#define PG8_SCHED __builtin_amdgcn_sched_barrier(0)
    Unit cur, nxt; int ui = 0;
    if (!S.next(0, cur)) return;
    f32x4 acc[2][2][4][2];
#pragma unroll
    for (int a = 0; a < 2; ++a)
#pragma unroll
        for (int b = 0; b < 2; ++b)
#pragma unroll
            for (int m = 0; m < 4; ++m)
#pragma unroll
                for (int n = 0; n < 2; ++n) acc[a][b][m][n] = (f32x4){0.f, 0.f, 0.f, 0.f};
    bf16x8 At[4][2], B0[2][2], B1[2][2];
    const char* cA = PG8_UA(cur); const char* cB = PG8_UB(cur);
    S.a_ready(cur);
    if constexpr (SP2) {
        PG8_STAGE(PG8_SB(0, 0), cB, voffB); PG8_STAGE(PG8_SB(0, 1), cB + hstepB, voffB); PG8_STAGE(PG8_SA(0, 0), cA, voffA); PG8_STAGE(PG8_SA(0, 1), cA + hstepA, voffA);
        if (wr == 1) PG8_BAR;
        PG8_WAIT_V(2); PG8_BAR;
        PG8_STAGE(PG8_SB(1, 0), cB + kstep, voffB); PG8_STAGE(PG8_SA(1, 0), cA + kstep, voffA); PG8_STAGE(PG8_SB(1, 1), cB + hstepB + kstep, voffB);
        PG8_WAIT_V(6); PG8_BAR;
    } else {
        PG8_STAGE(PG8_SB(0, 0), cB, voffB); PG8_STAGE(PG8_SA(0, 0), cA, voffA); PG8_STAGE(PG8_SB(0, 1), cB + hstepB, voffB); PG8_STAGE(PG8_SA(0, 1), cA + hstepA, voffA);
        if (wr == 1) PG8_BAR;
        PG8_WAIT_V(4); PG8_BAR;
        PG8_STAGE(PG8_SB(1, 0), cB + kstep, voffB); PG8_STAGE(PG8_SA(1, 0), cA + kstep, voffA); PG8_STAGE(PG8_SB(1, 1), cB + hstepB + kstep, voffB);
        PG8_WAIT_V(6); PG8_BAR;
    }
    for (;;) {
        const bool has_next = S.next(ui + 1, nxt);
        const char* nA = has_next ? PG8_UA(nxt) : cA; const char* nB = has_next ? PG8_UB(nxt) : cB;
        for (int t = 0; t < nt; t += 2) {
            const bool last = (t == nt - 2);
            const char* a1 = cA + (size_t)(t + 1) * kstep;
            const char* a2 = last ? nA : cA + (size_t)(t + 2) * kstep; const char* b2 = last ? nB : cB + (size_t)(t + 2) * kstep;
            const char* a3 = a2 + kstep; const char* b3 = b2 + kstep;
            if (last && has_next) S.a_ready(nxt);
            if constexpr (SP2) {
            PG8_LDB(B0, 0, 0); PG8_LDB(B1, 0, 1); PG8_SCHED; PG8_LDA(At, 0, 0); PG8_STAGE(PG8_SA(1, 1), a1 + hstepA, voffA);
            PG8_WAIT_V(8); PG8_WAIT_L(0); PG8_BAR; PG8_MMA(0, 0, At, B0); PG8_MMA(0, 1, At, B1); PG8_BAR; PG8_SCHED;
            PG8_LDA(At, 0, 1); PG8_STAGE(PG8_SB(0, 0), b2, voffB); PG8_STAGE(PG8_SB(0, 1), b2 + hstepB, voffB); PG8_STAGE(PG8_SA(0, 0), a2, voffA);
            PG8_WAIT_V(8); PG8_WAIT_L(0); PG8_BAR; PG8_MMA(1, 0, At, B0); PG8_MMA(1, 1, At, B1); PG8_BAR; PG8_SCHED;
            PG8_LDB(B0, 1, 0); PG8_LDB(B1, 1, 1); PG8_SCHED; PG8_LDA(At, 1, 0); PG8_STAGE(PG8_SA(0, 1), a2 + hstepA, voffA);
            PG8_WAIT_V(8); PG8_WAIT_L(0); PG8_BAR; PG8_MMA(0, 0, At, B0); PG8_MMA(0, 1, At, B1); PG8_BAR; PG8_SCHED;
            PG8_LDA(At, 1, 1); PG8_STAGE(PG8_SB(1, 0), b3, voffB); PG8_STAGE(PG8_SB(1, 1), b3 + hstepB, voffB); PG8_STAGE(PG8_SA(1, 0), a3, voffA);
            PG8_WAIT_V(8); PG8_WAIT_L(0); PG8_BAR; PG8_MMA(1, 0, At, B0); PG8_MMA(1, 1, At, B1); PG8_BAR; PG8_SCHED;
            } else {
            PG8_LDB(B0, 0, 0); PG8_SCHED; PG8_LDA(At, 0, 0); PG8_STAGE(PG8_SA(1, 1), a1 + hstepA, voffA);
            PG8_WAIT_L(8); PG8_BAR; PG8_WAIT_L(0); PG8_MMA(0, 0, At, B0); PG8_BAR; PG8_SCHED;
            PG8_LDB(B1, 0, 1); PG8_STAGE(PG8_SB(0, 0), b2, voffB);
            PG8_BAR; PG8_WAIT_L(0); PG8_MMA(0, 1, At, B1); PG8_BAR;
            PG8_LDA(At, 0, 1); PG8_STAGE(PG8_SA(0, 0), a2, voffA);
            PG8_BAR; PG8_WAIT_L(0); PG8_MMA(1, 0, At, B0); PG8_BAR; PG8_SCHED;
            PG8_STAGE(PG8_SB(0, 1), b2 + hstepB, voffB);
            PG8_WAIT_V(6); PG8_BAR; PG8_MMA(1, 1, At, B1); PG8_BAR;
            PG8_LDB(B0, 1, 0); PG8_SCHED; PG8_LDA(At, 1, 0); PG8_STAGE(PG8_SA(0, 1), a2 + hstepA, voffA);
            PG8_WAIT_L(8); PG8_BAR; PG8_WAIT_L(0); PG8_MMA(0, 0, At, B0); PG8_BAR; PG8_SCHED;
            PG8_LDB(B1, 1, 1); PG8_STAGE(PG8_SB(1, 0), b3, voffB);
            PG8_BAR; PG8_WAIT_L(0); PG8_MMA(0, 1, At, B1); PG8_BAR;
            PG8_LDA(At, 1, 1); PG8_STAGE(PG8_SA(1, 0), a3, voffA);
            PG8_BAR; PG8_WAIT_L(0); PG8_MMA(1, 0, At, B0); PG8_BAR; PG8_SCHED;
            PG8_STAGE(PG8_SB(1, 1), b3 + hstepB, voffB);
            PG8_WAIT_V(6); PG8_BAR; PG8_MMA(1, 1, At, B1); PG8_BAR;
            }
        }
        if constexpr (ALIGN_EPI) { if (wr == 0) PG8_BAR; }
        E(acc, cur, wr, wc, fr, fq); S.done(cur, lane);
        if (!has_next) break;
#pragma unroll
        for (int a = 0; a < 2; ++a)
#pragma unroll
            for (int b = 0; b < 2; ++b)
#pragma unroll
                for (int m = 0; m < 4; ++m)
#pragma unroll
                    for (int n = 0; n < 2; ++n) acc[a][b][m][n] = (f32x4){0.f, 0.f, 0.f, 0.f};
        cur = nxt; cA = nA; cB = nB; ++ui;
        if constexpr (ALIGN_EPI) { if (wr == 1) PG8_BAR; }
    }
    PG8_WAIT_V(0);
    if constexpr (!ALIGN_EPI) { if (wr == 0) PG8_BAR; }
    PG8_BAR;
#undef PG8_UA
#undef PG8_UB
#undef PG8_SA
#undef PG8_SB
#undef PG8_STAGE
#undef PG8_LDA
#undef PG8_LDB
#undef PG8_MMA
#undef PG8_WAIT_V
#undef PG8_WAIT_L
#undef PG8_BAR
#undef PG8_SCHED
}
}

using pg8::Unit; using pg8::cvt_pk_bf16;
#define LDS_WAIT() asm volatile("s_waitcnt lgkmcnt(0)" ::: "memory")
__device__ __forceinline__ float sigm(float z) { return __builtin_amdgcn_rcpf(1.0f + __builtin_amdgcn_exp2f(-1.4426950408889634f * z)); }
__device__ __forceinline__ float bflo(unsigned w) { return __builtin_bit_cast(float, w << 16); }
__device__ __forceinline__ float bfhi(unsigned w) { return __builtin_bit_cast(float, w & 0xffff0000u); }
__device__ __forceinline__ void bf8_to_f32(const u32x4 w, float (&f)[8]) { f[0] = bflo(w.x); f[1] = bfhi(w.x); f[2] = bflo(w.y); f[3] = bfhi(w.y); f[4] = bflo(w.z); f[5] = bfhi(w.z); f[6] = bflo(w.w); f[7] = bfhi(w.w); }
__device__ __forceinline__ u32x4 f32_to_bf8(const float (&f)[8]) { u32x4 w; w.x = cvt_pk_bf16(f[0], f[1]); w.y = cvt_pk_bf16(f[2], f[3]); w.z = cvt_pk_bf16(f[4], f[5]); w.w = cvt_pk_bf16(f[6], f[7]); return w; }
__device__ __forceinline__ float dpp_add(float v, const int ctrl_sel) {
    const int x = __builtin_bit_cast(int, v); int y;
    if (ctrl_sel == 0) y = __builtin_amdgcn_update_dpp(0, x, 0xB1, 0xf, 0xf, true);
    else if (ctrl_sel == 1) y = __builtin_amdgcn_update_dpp(0, x, 0x4E, 0xf, 0xf, true);
    else if (ctrl_sel == 2) y = __builtin_amdgcn_update_dpp(0, x, 0x141, 0xf, 0xf, true);
    else y = __builtin_amdgcn_update_dpp(0, x, 0x140, 0xf, 0xf, true);
    return v + __builtin_bit_cast(float, y);
}
__device__ __forceinline__ float wave_sum(float v) {
    v = dpp_add(v, 0); v = dpp_add(v, 1); v = dpp_add(v, 2); v = dpp_add(v, 3);
    const int x = __builtin_bit_cast(int, v);
    const float a = __builtin_bit_cast(float, __builtin_amdgcn_readlane(x, 0)), b = __builtin_bit_cast(float, __builtin_amdgcn_readlane(x, 16));
    const float c = __builtin_bit_cast(float, __builtin_amdgcn_readlane(x, 32)), d = __builtin_bit_cast(float, __builtin_amdgcn_readlane(x, 48));
    return (a + b) + (c + d);
}

__device__ __forceinline__ int dest_row(int kind, int n) {
    if (kind == 0) { const int part = n >> 11, e = n & 2047, pn = e >> 6, el = e & 63; const int cg = (el >> 2) & 3, sg = ((cg & 1) << 1) | (cg >> 1); return pn * 256 + (part >> 1) * 128 + (el >> 4) * 32 + (part & 1) * 16 + sg * 4 + (el & 3); }
    if (kind == 1) { const int part = n >> 11, e = n & 2047, pn = e >> 7, el = e & 127; return pn * 256 + part * 128 + (el >> 5) * 32 + ((el >> 2) & 1) * 16 + ((el >> 3) & 3) * 4 + (el & 3); }
    const int cl = n & 255; return (n & ~255) + (cl & 0xE0) + ((cl >> 2) & 1) * 16 + ((cl >> 3) & 3) * 4 + (cl & 3);
}
__device__ __forceinline__ void prompt_unit(int L, int nN, Unit& u) {
    const int per = 8 * nN, w = (L & 7) * per + (L >> 3), r = w % per;
    u.pm = (w / per) * 8 + (r & 7); u.pn = r >> 3;
}
__device__ __forceinline__ void wait_count(const unsigned* cnt, unsigned need) {
    if (threadIdx.x < 64) {
        unsigned sp = 0;
        while ((unsigned)__builtin_amdgcn_readfirstlane(__hip_atomic_load(cnt, __ATOMIC_RELAXED, __HIP_MEMORY_SCOPE_AGENT)) < need) { __builtin_amdgcn_s_sleep(2); if (++sp > (1u << 21)) break; }
        __builtin_amdgcn_fence(__ATOMIC_ACQUIRE, "agent");
        asm volatile("s_waitcnt vmcnt(0)" ::: "memory");
    }
    asm volatile("" ::: "memory"); __builtin_amdgcn_s_barrier(); asm volatile("" ::: "memory");
}
__device__ __forceinline__ void count_in(unsigned* cnt, int lane) {
    asm volatile("s_waitcnt vmcnt(0)" ::: "memory");
    if (lane == 0) __hip_atomic_fetch_add(cnt, 1u, __ATOMIC_RELAXED, __HIP_MEMORY_SCOPE_AGENT);
}

typedef __amdgpu_buffer_rsrc_t rsrc_t;
__device__ __forceinline__ rsrc_t mk_rsrc(const void* p, unsigned bytes) { return __builtin_amdgcn_make_buffer_rsrc((void*)p, 0, bytes, 0x00020000); }
__device__ __forceinline__ void st16_wt(rsrc_t r, unsigned byte_off, u32x4 v) { __builtin_amdgcn_raw_buffer_store_b128(v, r, byte_off, 0, 16); }
__device__ __forceinline__ void st8_wt(void* p, u32x2 v) { __hip_atomic_store((unsigned long long*)p, __builtin_bit_cast(unsigned long long, v), __ATOMIC_RELAXED, __HIP_MEMORY_SCOPE_AGENT); }
__device__ __forceinline__ float dpp_shr1(float v) { return __builtin_bit_cast(float, __builtin_amdgcn_update_dpp(0, __builtin_bit_cast(int, v), 0x111, 0xf, 0xf, true)); }
__device__ __forceinline__ float dpp_shr2(float v) { return __builtin_bit_cast(float, __builtin_amdgcn_update_dpp(0, __builtin_bit_cast(int, v), 0x112, 0xf, 0xf, true)); }
__device__ __forceinline__ void st_pair(bf16_t* Y0, int t, int e0, int hi32, u32x2 a, u32x2 b) {
    const auto rx = __builtin_amdgcn_permlane32_swap(a.x, b.x, false, false), ry = __builtin_amdgcn_permlane32_swap(a.y, b.y, false, false);
    *(u32x4*)(Y0 + (size_t)(t + hi32) * E + (e0 - 4 * hi32)) = (u32x4){rx[0], ry[0], rx[1], ry[1]};
}
struct Epi1 {
    LAS unsigned char* tab; bf16_t* Y0; float* HCV; float* PGB; float* PCV; const float* st_conv; float* out;
    __device__ __forceinline__ void operator()(const f32x4 (&acc)[2][2][4][2], const Unit& u, int wr, int wc, int fr, int fq) const {
        const int cgq = ((fq & 1) << 1) | (fq >> 1);
        const int e0 = u.pn * 64 + wc * 16 + cgq * 4;
        const int t0 = u.pm * 256 + wr * 128 + fr * 8, hi32 = fq >> 1;
        const LAS unsigned char* tb = tab + (u.slot & 1) * 2048;
        const f32x4 ra = *(const LAS f32x4*)(tb + (wr * 128 + fr * 8) * 4), rb = *(const LAS f32x4*)(tb + (wr * 128 + fr * 8) * 4 + 16);
        f32x4 cv[8], g[8];
#pragma unroll
        for (int i = 0; i < 8; ++i) {
            const float r = i < 4 ? ra[i & 3] : rb[i & 3];
            const f32x4 gb = acc[i >> 2][0][i & 3][0] * r, gc = acc[i >> 2][0][i & 3][1] * r, v = acc[i >> 2][1][i & 3][0] * r, z = acc[i >> 2][1][i & 3][1] * r;
            cv[i] = gc * v;
#pragma unroll
            for (int j = 0; j < 4; ++j) g[i][j] = gb[j] * z[j] * sigm(z[j]);
        }
        const LAS f32x4* wp = (const LAS f32x4*)(tb + 1024 + (wc * 16 + cgq * 4) * 4);
        const f32x4 w0 = wp[0], w1 = wp[16], w2 = wp[32], bb = wp[48];
        if (u.pm >= MP / 256) {
            const int s0 = t0 - MP, b0 = s0 >> 2;
#pragma unroll
            for (int q = 0; q < 2; ++q) {
                const float* st = st_conv + ((size_t)(b0 + q) * 2) * E + e0;
                const f32x4 h0 = *(const f32x4*)st, h1 = *(const f32x4*)(st + E);
                u32x2 w[4];
#pragma unroll
                for (int k = 0; k < 4; ++k) { const int i = 4 * q + k;
                    const f32x4 cm2 = k >= 2 ? cv[i - 2] : (k == 0 ? h0 : h1), cm1 = k >= 1 ? cv[i - 1] : h1;
                    const f32x4 y = g[i] * (bb + w0 * cm2 + w1 * cm1 + w2 * cv[i]);
                    w[k].x = cvt_pk_bf16(y[0], y[1]); w[k].y = cvt_pk_bf16(y[2], y[3]); }
                st_pair(Y0, t0 + 4 * q, e0, hi32, w[0], w[1]); st_pair(Y0, t0 + 4 * q + 2, e0, hi32, w[2], w[3]);
                float* o = out + O_NCS + ((size_t)(b0 + q) * 2) * E + e0;
                *(f32x4*)o = cv[4 * q + 2]; *(f32x4*)(o + E) = cv[4 * q + 3];
            }
            return;
        }
        f32x4 hm2, hm1;
#pragma unroll
        for (int j = 0; j < 4; ++j) { hm2[j] = dpp_shr1(cv[6][j]); hm1[j] = dpp_shr1(cv[7][j]); }
#pragma unroll
        for (int i = 0; i < 8; i += 2) {
            u32x2 w[2];
#pragma unroll
            for (int k = 0; k < 2; ++k) { const int t = i + k;
                const f32x4 cm2 = t >= 2 ? cv[t - 2] : (t == 0 ? hm2 : hm1), cm1 = t >= 1 ? cv[t - 1] : hm1;
                const f32x4 y = g[t] * (bb + w0 * cm2 + w1 * cm1 + w2 * cv[t]);
                w[k].x = cvt_pk_bf16(y[0], y[1]); w[k].y = cvt_pk_bf16(y[2], y[3]); }
            if (i >= 2 || fr != 0) st_pair(Y0, t0 + i, e0, hi32, w[0], w[1]);
        }
        const int run = 2 * u.pm + wr;
        if (fr == 0) {
            *(f32x4*)(PGB + ((size_t)run * 2 + 0) * E + e0) = g[0]; *(f32x4*)(PGB + ((size_t)run * 2 + 1) * E + e0) = g[1];
            *(f32x4*)(PCV + ((size_t)run * 2 + 0) * E + e0) = cv[0]; *(f32x4*)(PCV + ((size_t)run * 2 + 1) * E + e0) = cv[1];
        }
        if (fr == 15) {
            *(f32x4*)(HCV + ((size_t)run * 2 + 0) * E + e0) = cv[6]; *(f32x4*)(HCV + ((size_t)run * 2 + 1) * E + e0) = cv[7];
            if ((run & 15) == 15) { *(f32x4*)(out + O_NCP + ((size_t)(run >> 4) * 2 + 0) * E + e0) = cv[6]; *(f32x4*)(out + O_NCP + ((size_t)(run >> 4) * 2 + 1) * E + e0) = cv[7]; }
        }
    }
};
template <bool SSQ> struct EpiRes {
    bf16_t* XB; float* ssp;
    __device__ __forceinline__ void operator()(const f32x4 (&acc)[2][2][4][2], const Unit& u, int wr, int wc, int fr, int fq) const {
        const int col0 = u.pn * 256 + wc * 32 + fq * 8;
        const rsrc_t rx = mk_rsrc(XB, (unsigned)((size_t)M * D * 2));
#pragma unroll
        for (int ai = 0; ai < 2; ++ai)
#pragma unroll
            for (int m = 0; m < 4; ++m) {
                const int row = u.pm * 256 + ai * 128 + wr * 64 + m * 16 + fr;
                float ss = 0.f;
#pragma unroll
                for (int bj = 0; bj < 2; ++bj) {
                    const size_t off = (size_t)row * D + col0 + bj * 128;
                    float x[8]; bf8_to_f32(*(const u32x4*)(XB + off), x);
                    const f32x4 a0 = acc[ai][bj][m][0], a1 = acc[ai][bj][m][1];
                    float v[8];
#pragma unroll
                    for (int j = 0; j < 4; ++j) { v[j] = x[j] + a0[j]; v[4 + j] = x[4 + j] + a1[j]; }
                    if (SSQ) ss += ((v[0] * v[0] + v[1] * v[1]) + (v[2] * v[2] + v[3] * v[3])) + ((v[4] * v[4] + v[5] * v[5]) + (v[6] * v[6] + v[7] * v[7]));
                    st16_wt(rx, (unsigned)(off * 2), f32_to_bf8(v));
                }
                if (SSQ) { ss += __shfl_xor(ss, 16); ss += __shfl_xor(ss, 32);
                    if (fq == 0) __hip_atomic_store(ssp + (size_t)row * 16 + u.pn * 4 + wc, ss, __ATOMIC_RELAXED, __HIP_MEMORY_SCOPE_AGENT); }
            }
    }
};
struct EpiG5 {
    const bf16_t* XB; float* xs; unsigned* cnt; const float* gfin; float* outy; LAS unsigned char* tab; LAS unsigned char* stage;
    __device__ __forceinline__ void operator()(const f32x4 (&acc)[2][2][4][2], const Unit& u, int wr, int wc, int fr, int fq) const {
        const int col0 = u.pn * 256 + wc * 32 + fq * 8;
        f32x4 v[2][4][2][2];
#pragma unroll
        for (int ai = 0; ai < 2; ++ai)
#pragma unroll
            for (int m = 0; m < 4; ++m) {
                const int row = u.pm * 256 + ai * 128 + wr * 64 + m * 16 + fr;
                float ss = 0.f;
#pragma unroll
                for (int bj = 0; bj < 2; ++bj) {
                    float x[8]; bf8_to_f32(*(const u32x4*)(XB + (size_t)row * D + col0 + bj * 128), x);
                    const f32x4 a0 = acc[ai][bj][m][0], a1 = acc[ai][bj][m][1];
                    f32x4 v0, v1;
#pragma unroll
                    for (int j = 0; j < 4; ++j) { v0[j] = x[j] + a0[j]; v1[j] = x[4 + j] + a1[j]; }
                    ss += ((v0[0] * v0[0] + v0[1] * v0[1]) + (v0[2] * v0[2] + v0[3] * v0[3])) + ((v1[0] * v1[0] + v1[1] * v1[1]) + (v1[2] * v1[2] + v1[3] * v1[3]));
                    v[ai][m][bj][0] = v0; v[ai][m][bj][1] = v1;
                }
                ss += __shfl_xor(ss, 16); ss += __shfl_xor(ss, 32);
                if (fq == 0) __hip_atomic_store(xs + (size_t)row * 16 + u.pn * 4 + wc, ss, __ATOMIC_RELAXED, __HIP_MEMORY_SCOPE_AGENT);
            }
        asm volatile("s_waitcnt vmcnt(0)" ::: "memory"); __builtin_amdgcn_s_barrier();
        if (threadIdx.x == 0) __hip_atomic_fetch_add(cnt + 64 * u.pm, 1u, __ATOMIC_RELAXED, __HIP_MEMORY_SCOPE_AGENT);
        LAS unsigned char* stg = stage + (wr * 4 + wc) * 16384;
#pragma unroll
        for (int m = 0; m < 4; ++m)
#pragma unroll
            for (int bj = 0; bj < 2; ++bj)
#pragma unroll
                for (int h = 0; h < 2; ++h) *(LAS f32x4*)(stg + (m * 16 + fr) * 256 + (((bj * 8 + fq * 2 + h) ^ fr) << 4)) = v[0][m][bj][h];
        wait_count(cnt + 64 * u.pm, 4u);
        { const int t = threadIdx.x;
          if (t < 256) { const f32x4* sp = (const f32x4*)(xs + ((size_t)u.pm * 256 + t) * 16);
              const f32x4 st = (sp[0] + sp[1]) + (sp[2] + sp[3]);
              *(LAS float*)(tab + t * 4) = rsqrtf(((st[0] + st[1]) + (st[2] + st[3])) * (1.0f / D) + EPS); } }
        asm volatile("s_waitcnt lgkmcnt(0)" ::: "memory"); __builtin_amdgcn_s_barrier(); asm volatile("" ::: "memory");
        const int lane = fq * 16 + fr, c = lane & 15, rq = lane >> 4;
        const int colL = u.pn * 256 + (c >> 3) * 128 + wc * 32 + (c & 7) * 4;
        const f32x4 gl = *(const f32x4*)(gfin + colL);
#pragma unroll
        for (int ai = 0; ai < 2; ++ai) {
            if (ai == 1) {
#pragma unroll
                for (int m = 0; m < 4; ++m)
#pragma unroll
                    for (int bj = 0; bj < 2; ++bj)
#pragma unroll
                        for (int h = 0; h < 2; ++h) *(LAS f32x4*)(stg + (m * 16 + fr) * 256 + (((bj * 8 + fq * 2 + h) ^ fr) << 4)) = v[1][m][bj][h];
            }
            asm volatile("s_waitcnt lgkmcnt(0)" ::: "memory");
#pragma unroll
            for (int k = 0; k < 16; ++k) {
                const int r = k * 4 + rq, rl = ai * 128 + wr * 64 + r;
                const f32x4 val = *(const LAS f32x4*)(stg + r * 256 + ((c ^ (r & 15)) << 4));
                const float rs = *(const LAS float*)(tab + rl * 4);
                *(f32x4*)(outy + (size_t)(u.pm * 256 + rl) * D + colL) = val * rs * gl;
            }
            asm volatile("s_waitcnt lgkmcnt(0)" ::: "memory");
        }
    }
};
template <int W> __device__ __forceinline__ void pool_lane(const float (&x)[8], float (&p)[8]) {
    float pre[8]; pre[0] = x[0];
#pragma unroll
    for (int i = 1; i < 8; ++i) pre[i] = pre[i - 1] + x[i];
    const float S = pre[7];
    float win[8];
    if (W == 2) {
        const float h = dpp_shr1(x[7]);
#pragma unroll
        for (int i = 0; i < 8; ++i) win[i] = x[i] + (i >= 1 ? x[i - 1] : h);
    } else if (W == 4) {
#pragma unroll
        for (int i = 0; i < 8; ++i) win[i] = i >= 4 ? pre[i] - pre[i - 4] : (i == 3 ? pre[3] : pre[i] + dpp_shr1(S - pre[i + 4]));
    } else if (W == 8) {
#pragma unroll
        for (int i = 0; i < 8; ++i) win[i] = i == 7 ? pre[7] : pre[i] + dpp_shr1(S - pre[i]);
    } else {
        const float s1 = dpp_shr1(S);
#pragma unroll
        for (int i = 0; i < 8; ++i) win[i] = i == 7 ? pre[7] + s1 : pre[i] + s1 + dpp_shr2(S - pre[i]);
    }
#pragma unroll
    for (int i = 0; i < 8; ++i) p[i] = win[i] * (1.0f / W) - x[i];
}
struct Epi3 {
    LAS unsigned char* rsb;
    bf16_t* Y1; float* HV; float* PV; bf16_t* PSZ; float* SV; bf16_t* SSZ;
    __device__ __forceinline__ void operator()(const f32x4 (&acc)[2][2][4][2], const Unit& u, int wr, int wc, int fr, int fq) const {
        const int e0 = u.pn * 128 + wc * 32 + fq * 8;
        const int t0 = u.pm * 256 + wr * 128 + fr * 8;
        float r[8];
        { const LAS f32x4* rp = (const LAS f32x4*)(rsb + (u.slot & 1) * 1024 + (wr * 128 + fr * 8) * 4); const f32x4 r0 = rp[0], r1 = rp[1];
#pragma unroll
          for (int i = 0; i < 4; ++i) { r[i] = r0[i]; r[4 + i] = r1[i]; } }
        u32x4 szp[8];
#pragma unroll
        for (int i = 0; i < 8; ++i) {
            const f32x4 z0 = acc[i >> 2][1][i & 3][0] * r[i], z1 = acc[i >> 2][1][i & 3][1] * r[i];
            float sz[8];
#pragma unroll
            for (int j = 0; j < 4; ++j) { sz[j] = z0[j] * sigm(z0[j]); sz[4 + j] = z1[j] * sigm(z1[j]); }
            szp[i] = f32_to_bf8(sz);
        }
        f32x4 ua[8], ub[8];
#pragma unroll
        for (int i = 0; i < 8; ++i) { ua[i] = acc[i >> 2][0][i & 3][0] * r[i]; ub[i] = acc[i >> 2][0][i & 3][1] * r[i]; }
        if (u.pm >= MP / 256) {
            const int s0 = t0 - MP;
            const rsrc_t svr = mk_rsrc(SV, (unsigned)((size_t)MS * E * 4)), szr = mk_rsrc(SSZ, (unsigned)((size_t)MS * E * 2));
#pragma unroll
            for (int i = 0; i < 8; ++i) { const unsigned o = (unsigned)((size_t)(s0 + i) * E + e0);
                st16_wt(svr, o * 4, __builtin_bit_cast(u32x4, ua[i])); st16_wt(svr, o * 4 + 16, __builtin_bit_cast(u32x4, ub[i])); st16_wt(szr, o * 2, szp[i]); }
            return;
        }
        const int run = 2 * u.pm + wr;
        if (fr < 2) {
            const rsrc_t pvr = mk_rsrc(PV, (unsigned)((size_t)NRUN * 16 * E * 4)), pzr = mk_rsrc(PSZ, (unsigned)((size_t)NRUN * 16 * E * 2));
#pragma unroll
            for (int i = 0; i < 8; ++i) { const unsigned o = (unsigned)(((size_t)run * 16 + fr * 8 + i) * E + e0);
                st16_wt(pvr, o * 4, __builtin_bit_cast(u32x4, ua[i])); st16_wt(pvr, o * 4 + 16, __builtin_bit_cast(u32x4, ub[i])); st16_wt(pzr, o * 2, szp[i]); }
        }
        if (fr >= 14) {
            const rsrc_t hvr = mk_rsrc(HV, (unsigned)((size_t)NRUN * PH * E * 4));
#pragma unroll
            for (int i = 0; i < 8; ++i) { const int idx = fr * 8 + i - (128 - PH);
                if (idx >= 0) { const unsigned o = (unsigned)((((size_t)run * PH + idx) * E + e0) * 4); st16_wt(hvr, o, __builtin_bit_cast(u32x4, ua[i])); st16_wt(hvr, o + 16, __builtin_bit_cast(u32x4, ub[i])); } }
        }
        float pp[8][8];
        const int grp = u.pn >> 2;
#pragma unroll
        for (int c = 0; c < 8; ++c) {
            float x[8], p[8];
#pragma unroll
            for (int i = 0; i < 8; ++i) x[i] = c < 4 ? ua[i][c & 3] : ub[i][c & 3];
            if (grp == 0) pool_lane<2>(x, p); else if (grp == 1) pool_lane<4>(x, p); else if (grp == 2) pool_lane<8>(x, p); else pool_lane<16>(x, p);
#pragma unroll
            for (int i = 0; i < 8; ++i) pp[i][c] = p[i];
        }
        if (fr >= 2) {
            const rsrc_t y1r = mk_rsrc(Y1, (unsigned)((size_t)M * E * 2));
#pragma unroll
            for (int i = 0; i < 8; ++i) { float f[8]; bf8_to_f32(szp[i], f);
#pragma unroll
                for (int c = 0; c < 8; ++c) f[c] *= pp[i][c];
                st16_wt(y1r, (unsigned)(((size_t)(t0 + i) * E + e0) * 2), f32_to_bf8(f)); }
        }
    }
};
struct EpiWp {
    bf16_t* W3T;
    __device__ __forceinline__ void operator()(const f32x4 (&acc)[2][2][4][2], const Unit& u, int wr, int wc, int fr, int fq) const {
#pragma unroll
        for (int ai = 0; ai < 2; ++ai)
#pragma unroll
            for (int m = 0; m < 4; ++m) {
                const int e = u.pm * 256 + ai * 128 + wr * 64 + (m >> 1) * 32 + (fr >> 2) * 8 + (m & 1) * 4 + (fr & 3);
                bf16_t* rowp = W3T + (size_t)dest_row(1, e) * D + u.pn * 256 + wc * 32 + fq * 4;
#pragma unroll
                for (int bj = 0; bj < 2; ++bj)
#pragma unroll
                    for (int n = 0; n < 2; ++n) { const f32x4 v = acc[ai][bj][m][n]; u32x2 w; w.x = cvt_pk_bf16(v[0], v[1]); w.y = cvt_pk_bf16(v[2], v[3]); *(u32x2*)(rowp + bj * 128 + n * 16) = w; }
            }
    }
};
template <bool GATHER> struct EpiU {
    const float* ssp1; float* out;
    __device__ __forceinline__ void operator()(const f32x4 (&acc)[2][2][4][2], const Unit& u, int wr, int wc, int fr, int fq) const {
        const int col0 = u.pn * 256 + wc * 32 + fq * 8;
#pragma unroll
        for (int ai = 0; ai < (GATHER ? 1 : 2); ++ai)
#pragma unroll
            for (int m = 0; m < 4; ++m) {
                int row; float* dst; bool ok = true;
                if (GATHER) { const int b = wr * 4 + m; row = b * SEQ + (SEQ - 16) + fr; ok = fr >= 1; dst = out + O_NPP + ((size_t)b * PH + (fr >= 1 ? fr - 1 : 0)) * E; }
                else { row = u.pm * 256 + ai * 128 + wr * 64 + m * 16 + fr; const int rsn = row - MP; dst = out + O_NPS + ((size_t)(rsn >> 2) * PH + (PH - DSEQ) + (rsn & 3)) * E; }
                const f32x4* sp = (const f32x4*)(ssp1 + (size_t)row * 16);
                const f32x4 st = (sp[0] + sp[1]) + (sp[2] + sp[3]);
                const float r = rsqrtf(((st[0] + st[1]) + (st[2] + st[3])) * (1.0f / D) + EPS);
                if (ok) {
#pragma unroll
                    for (int bj = 0; bj < 2; ++bj) { *(f32x4*)(dst + col0 + bj * 128) = acc[ai][bj][m][0] * r; *(f32x4*)(dst + col0 + bj * 128 + 4) = acc[ai][bj][m][1] * r; } }
            }
    }
};
struct EpiHist {
    float* HP;
    __device__ __forceinline__ void operator()(const f32x4 (&acc)[2][2][4][2], const Unit& u, int wr, int wc, int fr, int fq) const {
        const int col0 = u.pn * 256 + wc * 32 + fq * 8;
        const rsrc_t hr = mk_rsrc(HP, (unsigned)((size_t)2048 * E * 4));
#pragma unroll
        for (int ai = 0; ai < 2; ++ai)
#pragma unroll
            for (int m = 0; m < 4; ++m) { const unsigned ro = (unsigned)(((size_t)(u.pm * 256 + ai * 128 + wr * 64 + m * 16 + fr) * E + col0) * 4);
#pragma unroll
                for (int bj = 0; bj < 2; ++bj) { st16_wt(hr, ro + bj * 512, __builtin_bit_cast(u32x4, acc[ai][bj][m][0])); st16_wt(hr, ro + bj * 512 + 16, __builtin_bit_cast(u32x4, acc[ai][bj][m][1])); } }
    }
};

#define XB_TMO      128
#define XB_XCNT(j)  (256  + 64 * (j))
#define XB_XSUB(j)  (1280 + 64 * (j))
#define XB_XGEN(j)  (2304 + 64 * (j))
#define XB_TOP      3328
#define XB_TOPGEN   3392
#define XCD_BAR_WORDS 3456
#define XB_SPIN_CAP (1u << 18)
__device__ __forceinline__ unsigned xb_ld(unsigned* p)              { return __hip_atomic_load(p, __ATOMIC_RELAXED, __HIP_MEMORY_SCOPE_AGENT); }
__device__ __forceinline__ unsigned xb_add(unsigned* p, unsigned v) { return __hip_atomic_fetch_add(p, v, __ATOMIC_RELAXED, __HIP_MEMORY_SCOPE_AGENT); }
__device__ __forceinline__ unsigned xb_xcc_id() { return (unsigned)__builtin_amdgcn_s_getreg((3 << 11) | 20) & 0xFu; }
#define XB_SPIN(cond, bar) do { unsigned _sp = 0; while (cond) { __builtin_amdgcn_s_sleep(1); \
    if ((++_sp & 255u) == 0u) { if (xb_ld(&(bar)[XB_TMO])) break; if (_sp > XB_SPIN_CAP) { atomicAdd(&(bar)[XB_TMO], 1u); break; } } } } while (0)
struct XcdBarrier { unsigned* bar; unsigned x; volatile LAS unsigned* st; };
__device__ __forceinline__ XcdBarrier xcd_barrier_post(unsigned* bar, volatile LAS unsigned* st) {
    XcdBarrier b; b.bar = bar; b.x = xb_xcc_id(); b.st = st;
    if (threadIdx.x == 0) (void)xb_add(&bar[XB_XCNT(b.x)], 1u);
    return b;
}
__device__ __forceinline__ void xcd_barrier_complete(unsigned* bar, unsigned x, unsigned& nloc, unsigned& nx) {
    const unsigned G = gridDim.x * gridDim.y * gridDim.z;
    unsigned sum, cnt, mine, sp = 0u;
    for (;;) {
        sum = 0u; cnt = 0u; mine = 0u;
#pragma unroll
        for (unsigned j = 0; j < 16; ++j) { const unsigned c = xb_ld(&bar[XB_XCNT(j)]); sum += c; cnt += (c > 0u) ? 1u : 0u; mine = (j == x) ? c : mine; }
        if (sum == G) break;
        __builtin_amdgcn_s_sleep(1);
        if ((++sp & 255u) == 0u) { if (xb_ld(&bar[XB_TMO])) break; if (sp > XB_SPIN_CAP) { atomicAdd(&bar[XB_TMO], 1u); break; } }
    }
    nloc = mine > 0u ? mine : 1u; nx = cnt > 0u ? cnt : 1u;
}
__device__ __forceinline__ void xcd_barrier(const XcdBarrier& b) {
    asm volatile("s_waitcnt vmcnt(0)" ::: "memory");
    __syncthreads();
    if (threadIdx.x == 0) {
        unsigned* bar = b.bar;
        __builtin_amdgcn_s_waitcnt(0);
        unsigned nloc = b.st[0], nx = b.st[1];
        if (nloc == 0u) { xcd_barrier_complete(bar, b.x, nloc, nx); b.st[0] = nloc; b.st[1] = nx; }
        const unsigned old = xb_add(&bar[XB_XSUB(b.x)], 1u);
        const unsigned gen = old / nloc;
        if (old + 1u == (gen + 1u) * nloc) {
            __builtin_amdgcn_fence(__ATOMIC_RELEASE, "agent");
            asm volatile("s_waitcnt vmcnt(0)" ::: "memory");
            const unsigned og = xb_add(&bar[XB_TOP], 1u);
            const unsigned tg = og / nx;
            if (og + 1u == (tg + 1u) * nx) xb_add(&bar[XB_TOPGEN], 1u);
            else XB_SPIN(xb_ld(&bar[XB_TOPGEN]) == tg, bar);
            __builtin_amdgcn_fence(__ATOMIC_ACQUIRE, "agent");
            xb_add(&bar[XB_XGEN(b.x)], 1u);
            asm volatile("s_waitcnt vmcnt(0)" ::: "memory");
        } else {
            XB_SPIN(xb_ld(&bar[XB_XGEN(b.x)]) == gen, bar);
            __builtin_amdgcn_fence(__ATOMIC_ACQUIRE, "agent");
            asm volatile("s_waitcnt vmcnt(0)" ::: "memory");
        }
    }
    __syncthreads();
}

__device__ __forceinline__ void p0_item_load(const float* W, int N, int item, int lane, float (&wv)[32]) {
    const int nblk = N / 32, kb = item / nblk, nb = item % nblk, k0 = 64 * kb, n0 = 32 * nb;
#pragma unroll
    for (int i = 0; i < 32; ++i) wv[i] = __builtin_nontemporal_load(W + (size_t)(k0 + 2 * i + (lane >> 5)) * N + n0 + (lane & 31));
}
template <bool WTHRU = false> __device__ __forceinline__ void p0_item_finish(float (&wv)[32], int K, int N, const float* gk, bf16_t* WT, int row_off, int kind, LAS float* scr, int item, int lane) {
    const int nblk = N / 32, kb = item / nblk, nb = item % nblk, k0 = 64 * kb, n0 = 32 * nb;
    if (gk) {
#pragma unroll
        for (int i = 0; i < 32; ++i) wv[i] *= gk[k0 + 2 * i + (lane >> 5)]; }
#pragma unroll
    for (int i = 0; i < 32; ++i) scr[(2 * i + (lane >> 5)) * 33 + (lane & 31)] = wv[i];
    LDS_WAIT(); asm volatile("" ::: "memory");
    const int c = lane & 7;
#pragma unroll
    for (int j = 0; j < 4; ++j) { const int n = (lane >> 3) + 8 * j; const LAS float* s = scr + (8 * c) * 33 + n;
        u32x4 o; o.x = cvt_pk_bf16(s[0 * 33], s[1 * 33]); o.y = cvt_pk_bf16(s[2 * 33], s[3 * 33]); o.z = cvt_pk_bf16(s[4 * 33], s[5 * 33]); o.w = cvt_pk_bf16(s[6 * 33], s[7 * 33]);
        if constexpr (WTHRU) st16_wt(mk_rsrc(WT, 0x7fffffffu), (unsigned)(((size_t)(row_off + dest_row(kind, n0 + n)) * K + k0 + 8 * c) * 2), o);
        else *(u32x4*)(WT + (size_t)(row_off + dest_row(kind, n0 + n)) * K + k0 + 8 * c) = o; }
    LDS_WAIT(); asm volatile("" ::: "memory");
}
template <bool WTHRU = false> __device__ __forceinline__ void p0_transpose_item(const float* W, int K, int N, const float* gk, bf16_t* WT, int row_off, int kind, LAS float* scr, int item, int lane) {
    float wv[32]; p0_item_load(W, N, item, lane, wv); p0_item_finish<WTHRU>(wv, K, N, gk, WT, row_off, kind, scr, item, lane);
}

struct SchedG1 : pg8::StaticOrder {
    const float* rs0; const float* conv_w; const float* conv_b; LAS unsigned char* tab;
    __device__ __forceinline__ void a_ready(const Unit& u) const {
        const int lane = threadIdx.x & 63, wave = __builtin_amdgcn_readfirstlane(threadIdx.x >> 6);
        LAS unsigned char* t = tab + (u.slot & 1) * 2048;
        if (wave == 0) __builtin_amdgcn_global_load_lds((const unsigned*)(rs0 + (size_t)u.pm * 256 + lane * 4), (LAS unsigned*)t, 16, 0, 0);
        else if (wave == 1) { const int a = lane >> 4, c4 = (lane & 15) * 4;
            const float* src = (a < 3 ? conv_w + (size_t)a * E : conv_b) + u.pn * 64 + c4;
            __builtin_amdgcn_global_load_lds((const unsigned*)src, (LAS unsigned*)(t + 1024), 16, 0, 0); }
    }
};
struct SchedG2 {
    int c; unsigned* cnt2;
    __device__ __forceinline__ bool next(int i, Unit& u) const { u.slot = i & 1; if (i == 0) { prompt_unit(c, 4, u); return true; } if (i == 1 && c < 8) { u.pm = 64 + (c >> 2); u.pn = c & 3; return true; } return false; }
    __device__ __forceinline__ void a_ready(const Unit&) const {}
    __device__ __forceinline__ void done(const Unit& u, int) const {
        asm volatile("s_waitcnt vmcnt(0)" ::: "memory"); __builtin_amdgcn_s_barrier();
        if (threadIdx.x == 0) __hip_atomic_fetch_add(cnt2 + 64 * u.pm, 1u, __ATOMIC_RELAXED, __HIP_MEMORY_SCOPE_AGENT); }
};
struct SchedG3 {
    int c; const unsigned* cnt2; const float* ss1; LAS unsigned char* rsb; unsigned* cntv;
    __device__ __forceinline__ bool next(int i, Unit& u) const {
        const int x = c & 7, j = (c >> 3) & 7, q = c >> 6;
        if (c < 8) { if (i >= 2) return false; u.pm = 8 * c; u.pn = i; u.slot = i ? 2 : 0; return true; }
        const bool smp = (j == 0 && q == 3) || (j == 1 && q <= 2), shed = j == 0 && (q == 1 || q == 2);
        if (smp) {
            if (i > 4) return false;
            if (i == 2) { const int sidx = j == 0 ? x : 8 + 8 * q + x; u.pm = 64 + (sidx >> 4); u.pn = sidx & 15; u.slot = 1; return true; }
            const int o = i < 2 ? i : i - 1; u.pm = 8 * x + j; u.pn = 4 * q + o; u.slot = i ? 2 : 0; return true;
        }
        if (i < 4) { u.pm = 8 * x + j; u.pn = 4 * q + i; u.slot = i ? 2 : 0; return true; }
        if (i == 4 && shed) { u.pm = 8 * x; u.pn = 1 + q; u.slot = 2; return true; }
        return false;
    }
    __device__ __forceinline__ int panel_units() const { const int j = (c >> 3) & 7, q = c >> 6; return c < 8 ? 2 : (j == 0 && (q == 1 || q == 2)) ? 5 : 4; }
    __device__ __forceinline__ bool has_sample() const { const int j = (c >> 3) & 7, q = c >> 6; return c >= 8 && ((j == 0 && q == 3) || (j == 1 && q <= 2)); }
    __device__ __forceinline__ void a_ready(const Unit& u) const {
        if (u.slot & 2) return;
        wait_count(cnt2 + 64 * u.pm, 4u);
        const int t = threadIdx.x;
        if (t < 256) { const f32x4* sp = (const f32x4*)(ss1 + ((size_t)u.pm * 256 + t) * 16);
            const f32x4 st = (sp[0] + sp[1]) + (sp[2] + sp[3]);
            *(LAS float*)(rsb + (u.slot & 1) * 1024 + t * 4) = rsqrtf(((st[0] + st[1]) + (st[2] + st[3])) * (1.0f / D) + EPS); }
    }
    __device__ __forceinline__ void done(const Unit& u, int) const {
        if (u.pm >= MP / 256) { asm volatile("s_waitcnt vmcnt(0)" ::: "memory"); __builtin_amdgcn_s_barrier();
            if (threadIdx.x == 0) __hip_atomic_fetch_add(cntv, 1u, __ATOMIC_RELAXED, __HIP_MEMORY_SCOPE_AGENT); }
    }
};
struct SchedOne {
    int pm, pn; bool has;
    __device__ __forceinline__ bool next(int i, Unit& u) const { u.slot = 0; if (has && i == 0) { u.pm = pm; u.pn = pn; return true; } return false; }
    __device__ __forceinline__ void a_ready(const Unit&) const {}
    __device__ __forceinline__ void done(const Unit&, int) const {}
};
struct SchedG5 {
    int c;
    __device__ __forceinline__ bool next(int i, Unit& u) const { u.slot = 0; if (i == 0) { prompt_unit(c, 4, u); return true; } return false; }
    __device__ __forceinline__ void a_ready(const Unit&) const {}
    __device__ __forceinline__ void done(const Unit&, int) const {}
};

template <int W, int NT> __device__ __forceinline__ void pool_slide(const float* hist, bool zero_hist, const float* cur, const bf16_t* sz, bf16_t* y1) {
    f32x4 x[W - 1 + NT]; u32x2 zw[NT];
#pragma unroll
    for (int i = 0; i < W - 1; ++i) x[i] = zero_hist ? (f32x4){0.f, 0.f, 0.f, 0.f} : *(const f32x4*)(hist + (size_t)(PH - (W - 1) + i) * E);
#pragma unroll
    for (int t = 0; t < NT; ++t) { x[W - 1 + t] = *(const f32x4*)(cur + (size_t)t * E); zw[t] = *(const u32x2*)(sz + (size_t)t * E); }
    f32x4 s = (f32x4){0.f, 0.f, 0.f, 0.f};
#pragma unroll
    for (int i = 0; i < W - 1; ++i) s += x[i];
#pragma unroll
    for (int t = 0; t < NT; ++t) {
        s += x[W - 1 + t];
        const float inv = 1.0f / (float)((zero_hist && t + 1 < W) ? t + 1 : W);
        const f32x4 c = x[W - 1 + t];
        u32x2 o; o.x = cvt_pk_bf16((s[0] * inv - c[0]) * bflo(zw[t].x), (s[1] * inv - c[1]) * bfhi(zw[t].x)); o.y = cvt_pk_bf16((s[2] * inv - c[2]) * bflo(zw[t].y), (s[3] * inv - c[3]) * bfhi(zw[t].y));
        *(u32x2*)(y1 + (size_t)t * E) = o;
        s -= x[t];
    }
}
template <int W> __device__ __forceinline__ void pool_slide_smp(const float* hist, const float* cur, const bf16_t* sz, rsrc_t y1r, unsigned y1off) {
    f32x4 xa[W - 1 + DSEQ], xb[W - 1 + DSEQ]; u32x4 zw[DSEQ];
#pragma unroll
    for (int i = 0; i < W - 1; ++i) { const float* hp = hist + (size_t)(PH - (W - 1) + i) * DB * E; xa[i] = *(const f32x4*)hp; xb[i] = *(const f32x4*)(hp + 4); }
#pragma unroll
    for (int t = 0; t < DSEQ; ++t) { xa[W - 1 + t] = *(const f32x4*)(cur + (size_t)t * E); xb[W - 1 + t] = *(const f32x4*)(cur + (size_t)t * E + 4); zw[t] = *(const u32x4*)(sz + (size_t)t * E); }
    f32x4 sa = (f32x4){0.f, 0.f, 0.f, 0.f}, sb = (f32x4){0.f, 0.f, 0.f, 0.f};
#pragma unroll
    for (int i = 0; i < W - 1; ++i) { sa += xa[i]; sb += xb[i]; }
    constexpr float inv = 1.0f / (float)W;
#pragma unroll
    for (int t = 0; t < DSEQ; ++t) {
        sa += xa[W - 1 + t]; sb += xb[W - 1 + t];
        const f32x4 ca = xa[W - 1 + t], cb = xb[W - 1 + t];
        u32x4 o;
        o.x = cvt_pk_bf16((sa[0] * inv - ca[0]) * bflo(zw[t].x), (sa[1] * inv - ca[1]) * bfhi(zw[t].x)); o.y = cvt_pk_bf16((sa[2] * inv - ca[2]) * bflo(zw[t].y), (sa[3] * inv - ca[3]) * bfhi(zw[t].y));
        o.z = cvt_pk_bf16((sb[0] * inv - cb[0]) * bflo(zw[t].z), (sb[1] * inv - cb[1]) * bfhi(zw[t].z)); o.w = cvt_pk_bf16((sb[2] * inv - cb[2]) * bflo(zw[t].w), (sb[3] * inv - cb[3]) * bfhi(zw[t].w));
        st16_wt(y1r, y1off + (unsigned)(t * E * 2), o);
        sa -= xa[t]; sb -= xb[t];
    }
}
template <int W> __device__ __forceinline__ void pool_fix_run(int r, int e, const float* HV, const float* PV, const bf16_t* PSZ, bf16_t* Y1) {
    const bool first = (r & 15) == 0;
    pool_slide<W, 16>(HV + ((size_t)(first ? r : r - 1) * PH) * E + e, first, PV + ((size_t)r * 16) * E + e, PSZ + ((size_t)r * 16) * E + e, Y1 + ((size_t)r * 128) * E + e);
}

struct Args { const float* in[14]; float* out; unsigned char* ws; };

__global__ void __launch_bounds__(512, 2) fwd_kernel(Args a) {
    extern __shared__ __attribute__((aligned(16))) unsigned char lds_raw[];
    LAS unsigned char* lds = (LAS unsigned char*)lds_raw;
    const int G = gridDim.x, bx = blockIdx.x;
    const int vcu = (G % 8 == 0) ? (bx % 8) * (G / 8) + bx / 8 : bx;
#define PHASE_IDS() int tid = threadIdx.x; asm volatile("" : "+v"(tid)); const int lane = tid & 63, wave = __builtin_amdgcn_readfirstlane(tid >> 6); \
    const int gw = vcu * 8 + wave, NGW = G * 8, gtid = vcu * 512 + tid, NGT = G * 512; (void)lane; (void)gw; (void)NGW; (void)gtid; (void)NGT
    const float* x_p = a.in[0]; const float* x_s = a.in[1]; const float* st_conv = a.in[2]; const float* st_pool = a.in[3];
    const float* norm_g = a.in[4]; const float* fin_g = a.in[5]; const float* w_in1 = a.in[6]; const float* conv_w = a.in[7]; const float* conv_b = a.in[8];
    const float* w_out1 = a.in[9]; const float* w_in2 = a.in[10]; const float* w_grp = a.in[11]; const float* p_scale = a.in[12]; const float* w_out2 = a.in[13];
    float* out = a.out; unsigned char* ws = a.ws;
    bf16_t* W1T = (bf16_t*)(ws + WS_W1T); bf16_t* W2T = (bf16_t*)(ws + WS_W2T); bf16_t* W3T = (bf16_t*)(ws + WS_W3T); bf16_t* W4T = (bf16_t*)(ws + WS_W4T); bf16_t* W5T = (bf16_t*)(ws + WS_W5T);
    bf16_t* WUB = (bf16_t*)(ws + WS_WUB); bf16_t* W3U = (bf16_t*)(ws + WS_W3U); bf16_t* SPB = (bf16_t*)(ws + WS_SPB);
    bf16_t* XB = (bf16_t*)(ws + WS_XB); bf16_t* BB = (bf16_t*)(ws + WS_B);
    float* HCV = (float*)(ws + WS_HCV); float* PGB = (float*)(ws + WS_PGB); float* PCV = (float*)(ws + WS_PCV);
    float* HV = (float*)(ws + WS_HV); float* PV = (float*)(ws + WS_PV); bf16_t* PSZ = (bf16_t*)(ws + WS_PSZ); float* SV = (float*)(ws + WS_SV); bf16_t* SSZ = (bf16_t*)(ws + WS_SSZ);
    float* HP = (float*)(ws + WS_HP); float* SLAB = (float*)(ws + WS_SLAB);
    float* rs0 = (float*)(ws + WS_RS0); float* ss1 = (float*)(ws + WS_SS1);
    volatile LAS unsigned* bst = (volatile LAS unsigned*)(lds + 131072 + 64);
    if (threadIdx.x < 2) bst[threadIdx.x] = 0u;
    __syncthreads();
    const XcdBarrier xbar = xcd_barrier_post((unsigned*)(ws + WS_CTL), bst);
#define GRID_SYNC() xcd_barrier(xbar)
    unsigned* cnt2 = (unsigned*)(ws + WS_CTL) + 4096; unsigned* cnt5 = cnt2 + 64 * 128;
#define CVT_HALF_ROW(src, dst, sc) do { f32x4 _v[4]; _Pragma("unroll") for (int _j = 0; _j < 4; ++_j) _v[_j] = __builtin_nontemporal_load((const f32x4*)((src) + (64 * _j + lane) * 4)); \
        _Pragma("unroll") for (int _j = 0; _j < 4; ++_j) { u32x2 _w; _w.x = cvt_pk_bf16(_v[_j][0] * (sc), _v[_j][1] * (sc)); _w.y = cvt_pk_bf16(_v[_j][2] * (sc), _v[_j][3] * (sc)); *(u32x2*)((dst) + (64 * _j + lane) * 4) = _w; } } while (0)

    {
        PHASE_IDS();
        LAS float* scr = (LAS float*)(lds + wave * 16384);
        constexpr int I1 = (D / 64) * (N1 / 32);
        static_assert(I1 == 2 * 256 * 8, "two weight items per wave on a 256-workgroup grid");
        float wa[32], wb[32];
        p0_item_load(w_in1, N1, gw, lane, wa); p0_item_load(w_in1, N1, gw + NGW, lane, wb);
        int row0 = gw * 2;
        f32x4 v[2][4], vn[2][4];
        { const float* xr = row0 < MP ? x_p + (size_t)row0 * D : x_s + (size_t)(row0 - MP) * D;
#pragma unroll
          for (int q = 0; q < 2; ++q)
#pragma unroll
            for (int j = 0; j < 4; ++j) v[q][j] = __builtin_nontemporal_load((const f32x4*)(xr + (size_t)q * D + (64 * j + lane) * 4)); }
        p0_item_finish(wa, D, N1, norm_g, W1T, 0, 0, scr, gw, lane);
        p0_item_finish(wb, D, N1, norm_g, W1T, 0, 0, scr, gw + NGW, lane);
        for (; row0 < M; row0 += NGW * 2) {
            const int rn = row0 + NGW * 2;
            if (rn < M) { const float* xr = rn < MP ? x_p + (size_t)rn * D : x_s + (size_t)(rn - MP) * D;
#pragma unroll
                for (int q = 0; q < 2; ++q)
#pragma unroll
                    for (int j = 0; j < 4; ++j) vn[q][j] = __builtin_nontemporal_load((const f32x4*)(xr + (size_t)q * D + (64 * j + lane) * 4)); }
            float ss[2];
#pragma unroll
            for (int q = 0; q < 2; ++q) { float a = 0.f;
#pragma unroll
                for (int j = 0; j < 4; ++j) a += (v[q][j][0] * v[q][j][0] + v[q][j][1] * v[q][j][1]) + (v[q][j][2] * v[q][j][2] + v[q][j][3] * v[q][j][3]);
                ss[q] = wave_sum(a); }
#pragma unroll
            for (int q = 0; q < 2; ++q)
#pragma unroll
                for (int j = 0; j < 4; ++j) { u32x2 w; w.x = cvt_pk_bf16(v[q][j][0], v[q][j][1]); w.y = cvt_pk_bf16(v[q][j][2], v[q][j][3]); *(u32x2*)(XB + (size_t)(row0 + q) * D + (64 * j + lane) * 4) = w; }
            if (lane < 2) rs0[row0 + lane] = rsqrtf((lane == 0 ? ss[0] : ss[1]) * (1.0f / D) + EPS);
#pragma unroll
            for (int q = 0; q < 2; ++q)
#pragma unroll
                for (int j = 0; j < 4; ++j) v[q][j] = vn[q][j];
        }
    }
    GRID_SYNC();

    {
        pg8::Gemm g{XB, W1T, M, N1, D, D, 0, 0, D, 0, 0}; SchedG1 S; S.init(M, N1, G, bx); S.rs0 = rs0; S.conv_w = conv_w; S.conv_b = conv_b; S.tab = lds + pg8::STAGE_BYTES + 1024;
        Epi1 Ep{lds + pg8::STAGE_BYTES + 1024, BB, HCV, PGB, PCV, st_conv, out};
        pg8::gemm_phase<Epi1, SchedG1, true, true, 1>(lds, g, S, Ep);
    }
    unsigned* cntW = cnt5 + 64 * 80;
    if (bx >= 64 && bx < 96) {
        const int idx = bx - 64;
        wait_count(cntW, (unsigned)(G - 96));
        pg8::Gemm g{W4T, WUB, E, D, GC, GC, 0, 0, E, 1, GC}; SchedOne S{idx >> 2, idx & 3, true};
        EpiWp Ep{W3T};
        pg8::gemm_phase<EpiWp, SchedOne, true, true, 0>(lds, g, S, Ep);
    } else if (bx >= 96) {
        PHASE_IDS();
        LAS float* scr = (LAS float*)(lds + wave * 16384);
        constexpr int IT = (D / 64) * (E / 32);
        const int tw = (bx - 96) * 8 + wave, NTW = (G - 96) * 8;
        { constexpr int I4 = (GC / 64) * (GC / 32);
          for (int it = tw; it < 4 * I4; it += NTW) { const int g = it / I4; p0_transpose_item<true>(w_grp + (size_t)g * GC * GC, GC, GC, nullptr, W4T, g * GC, 2, scr, it % I4, lane); }
          const rsrc_t ur = mk_rsrc(WUB, (unsigned)((size_t)D * E * 2));
          for (int it = tw; it < D * 2; it += NTW) { const int k = it >> 1, hf = it & 1; const float sc = norm_g[D + k]; const float* src = w_in2 + (size_t)k * N3 + hf * 1024;
              f32x4 va[2], vb[2];
#pragma unroll
              for (int j = 0; j < 2; ++j) { va[j] = __builtin_nontemporal_load((const f32x4*)(src + (64 * j + lane) * 8)); vb[j] = __builtin_nontemporal_load((const f32x4*)(src + (64 * j + lane) * 8 + 4)); }
#pragma unroll
              for (int j = 0; j < 2; ++j) { u32x4 o; o.x = cvt_pk_bf16(va[j][0] * sc, va[j][1] * sc); o.y = cvt_pk_bf16(va[j][2] * sc, va[j][3] * sc); o.z = cvt_pk_bf16(vb[j][0] * sc, vb[j][1] * sc); o.w = cvt_pk_bf16(vb[j][2] * sc, vb[j][3] * sc);
                  st16_wt(ur, (unsigned)(((size_t)k * E + hf * 1024 + (64 * j + lane) * 8) * 2), o); } }
          asm volatile("s_waitcnt vmcnt(0)" ::: "memory"); __syncthreads();
          if (tid == 0) __hip_atomic_fetch_add(cntW, 1u, __ATOMIC_RELAXED, __HIP_MEMORY_SCOPE_AGENT); }
        for (int it = tw; it < 4 * IT; it += NTW) {
            const int r = it & (IT - 1), kb = r >> 6, nb = r & 63;
            if (it >= 3 * IT) p0_transpose_item(w_out2, E, D, p_scale, W5T, 0, 2, scr, r, lane);
            else if (it < IT) p0_transpose_item(w_out1, E, D, nullptr, W2T, 0, 2, scr, r, lane);
            else if (it < 2 * IT) p0_transpose_item(w_in2, D, N3, norm_g + D, W3T, 0, 1, scr, kb * (N3 / 32) + 64 + nb, lane);
            else p0_transpose_item(w_in2, D, N3, norm_g + D, W3U, 0, 2, scr, kb * (N3 / 32) + nb, lane);
        }
        for (int it = tw; it < 2048 * 2; it += NTW) {
            const int row = it >> 1, hf = it & 1, drow = row < DB * PH ? (row % PH) * DB + row / PH : row;
            if (row < DB * PH) CVT_HALF_ROW(st_pool + (size_t)row * E + hf * 1024, SPB + (size_t)drow * E + hf * 1024, 1.0f);
            else {
#pragma unroll
                for (int j = 0; j < 4; ++j) *(u32x2*)(SPB + (size_t)row * E + hf * 1024 + (64 * j + lane) * 4) = (u32x2){0u, 0u}; }
        }
    }
    GRID_SYNC();
    {
        PHASE_IDS(); (void)gw;
        Unit u; prompt_unit(bx, 4, u);
        const int c = tid & 255, e = c * 8, run = 2 * u.pm + (tid >> 8);
        float w0[8], w1[8], w2[8], bb[8];
#pragma unroll
        for (int j = 0; j < 8; ++j) { w0[j] = conv_w[e + j]; w1[j] = conv_w[E + e + j]; w2[j] = conv_w[2 * E + e + j]; bb[j] = conv_b[e + j]; }
        float h0[8], h1[8], g0[8], g1[8], c0[8], c1[8];
        if (run & 15) { const float* h = HCV + ((size_t)(run - 1) * 2) * E + e;
#pragma unroll
            for (int j = 0; j < 8; ++j) { h0[j] = h[j]; h1[j] = h[E + j]; } }
        else {
#pragma unroll
            for (int j = 0; j < 8; ++j) { h0[j] = 0.f; h1[j] = 0.f; } }
        const float* pg = PGB + ((size_t)run * 2) * E + e; const float* pc = PCV + ((size_t)run * 2) * E + e;
#pragma unroll
        for (int j = 0; j < 8; ++j) { g0[j] = pg[j]; g1[j] = pg[E + j]; c0[j] = pc[j]; c1[j] = pc[E + j]; }
        float y0[8], y1[8];
#pragma unroll
        for (int j = 0; j < 8; ++j) { y0[j] = g0[j] * (bb[j] + w0[j] * h0[j] + w1[j] * h1[j] + w2[j] * c0[j]); y1[j] = g1[j] * (bb[j] + w0[j] * h1[j] + w1[j] * c0[j] + w2[j] * c1[j]); }
        *(u32x4*)(BB + ((size_t)run * 128) * E + e) = f32_to_bf8(y0); *(u32x4*)(BB + ((size_t)run * 128 + 1) * E + e) = f32_to_bf8(y1);
        asm volatile("s_waitcnt vmcnt(0)" ::: "memory"); __syncthreads();
    }
    {
        pg8::Gemm g{BB, W2T, M, D, E, E, 0, 0, E, 0, 0}; SchedG2 S{bx, cnt2};
        EpiRes<true> Ep{XB, ss1};
        pg8::gemm_phase<EpiRes<true>, SchedG2, true, true, 0>(lds, g, S, Ep);
    }
    const int jq = (bx >> 3) & 7;
    unsigned* cntG3 = cnt2 + 16384;
    unsigned* cntSV = cnt5 + 64 * 82; unsigned* cntHP = cnt5 + 64 * 83; unsigned* cntS2 = cnt5 + 64 * 84; unsigned* cntSL = cnt5 + 64 * 85;
    { const int i2 = (bx >> 6) * 8 + (bx & 7);
      const int hidx = (jq == 2 && i2 >= 16) ? i2 - 16 : bx < 8 ? 16 + bx : (jq == 3 && i2 < 6) ? 24 + i2 : -1;
      if (hidx >= 0) {
        const int hpm = hidx < 16 ? hidx >> 1 : hidx < 24 ? 4 + ((hidx - 16) >> 1) : hidx < 28 ? 6 + ((hidx - 24) >> 1) : 7;
        const int hpn = (hidx < 16 ? 6 : hidx < 24 ? 4 : hidx < 28 ? 2 : 0) + (hidx & 1);
        pg8::Gemm g{SPB, W4T, 2048, E, GC, E, 1, GC, GC, 0, 0}; SchedOne S{hpm, hpn, true};
        EpiHist Ep{HP};
        pg8::gemm_phase<EpiHist, SchedOne, true, true, 0>(lds, g, S, Ep);
        if (threadIdx.x == 0) __hip_atomic_fetch_add(cntHP, 1u, __ATOMIC_RELAXED, __HIP_MEMORY_SCOPE_AGENT);
      }
    }
    {
        pg8::Gemm g{XB, W3T, M, N3, D, D, 0, 0, D, 0, 0}; SchedG3 S{bx, cnt2, ss1, lds + pg8::STAGE_BYTES + 1024, cntSV};
        Epi3 Ep{lds + pg8::STAGE_BYTES + 1024, BB, HV, PV, PSZ, SV, SSZ};
        pg8::gemm_phase<Epi3, SchedG3, true, true, 1>(lds, g, S, Ep);
        if (threadIdx.x == 0) __hip_atomic_fetch_add(cntG3 + 64 * (8 * (bx & 7) + jq), (unsigned)S.panel_units(), __ATOMIC_RELAXED, __HIP_MEMORY_SCOPE_AGENT);
    }
    { const int i2 = (bx >> 6) * 8 + (bx & 7);
      if (jq == 2 && i2 < 16) {
        const int pm = 64 + (i2 >> 3);
        wait_count(cnt2 + 64 * pm, 4u);
        pg8::Gemm g{XB, W3U, M, E, D, D, 0, 0, D, 0, 0}; SchedOne S{pm, i2 & 7, true};
        EpiU<false> Ep{ss1, out};
        pg8::gemm_phase<EpiU<false>, SchedOne, true, true, 0>(lds, g, S, Ep);
      }
    }
    if (false) {
    } else if (jq == 1 && bx >= 192) {
        if (threadIdx.x < 64) { const int t = threadIdx.x; unsigned sp = 0;
            for (;;) { const bool rdy = t >= NB || __hip_atomic_load(cnt2 + 64 * (8 * (t < NB ? t : 0) + 7), __ATOMIC_RELAXED, __HIP_MEMORY_SCOPE_AGENT) >= 4u;
                if (__all(rdy)) break; __builtin_amdgcn_s_sleep(2); if (++sp > (1u << 21)) break; }
            __builtin_amdgcn_fence(__ATOMIC_ACQUIRE, "agent"); asm volatile("s_waitcnt vmcnt(0)" ::: "memory"); }
        __syncthreads();
        pg8::Gemm g{XB, W3U, M, E, D, D, 0, 0, D, 0, 0}; SchedOne S{0, bx & 7, true};
        EpiU<true> Ep{ss1, out};
        pg8::gemm_phase<EpiU<true>, SchedOne, true, true, 2>(lds, g, S, Ep);
    }
    if (bx >= 152) {
        const int tt = (bx - 152) * 512 + threadIdx.x, NTT = (G - 152) * 512;
        for (int i = tt; i < DB * (PH - DSEQ) * (E / 4); i += NTT) {
            const int b = i / ((PH - DSEQ) * (E / 4)), rem = i % ((PH - DSEQ) * (E / 4)), r = rem / (E / 4), c4 = rem % (E / 4);
            *(f32x4*)(out + O_NPS + ((size_t)b * PH + r) * E + c4 * 4) = *(const f32x4*)(st_pool + ((size_t)b * PH + DSEQ + r) * E + c4 * 4);
        }
    }
    if (jq == 4 || jq == 5) { PHASE_IDS(); (void)gw;
        const int sidx = (jq - 4) * 32 + (bx >> 6) * 8 + (bx & 7);
        if (tid < 64) { unsigned sp = 0;
            for (;;) { const bool rdy = lane >= 2 || __hip_atomic_load(lane == 0 ? cntSV : cntHP, __ATOMIC_RELAXED, __HIP_MEMORY_SCOPE_AGENT) >= (lane == 0 ? 32u : 30u);
                if (__all(rdy)) break; __builtin_amdgcn_s_sleep(16); if (++sp > (1u << 18)) break; }
            __builtin_amdgcn_fence(__ATOMIC_ACQUIRE, "agent"); asm volatile("s_waitcnt vmcnt(0)" ::: "memory"); }
        __syncthreads();
        const int b = sidx * 2 + (tid >> 8), c8 = tid & 255, es = c8 * 8, ws2 = c8 >> 6;
        const float* hp = HP + (size_t)b * E + es; const float* cp = SV + ((size_t)b * DSEQ) * E + es; const bf16_t* zp = SSZ + ((size_t)b * DSEQ) * E + es;
        const rsrc_t yr = mk_rsrc(BB + (size_t)MP * E, (unsigned)((size_t)MS * E * 2)); const unsigned yo = (unsigned)((((size_t)b * DSEQ) * E + es) * 2);
        if (ws2 == 0) pool_slide_smp<2>(hp, cp, zp, yr, yo); else if (ws2 == 1) pool_slide_smp<4>(hp, cp, zp, yr, yo);
        else if (ws2 == 2) pool_slide_smp<8>(hp, cp, zp, yr, yo); else pool_slide_smp<16>(hp, cp, zp, yr, yo);
        asm volatile("s_waitcnt vmcnt(0)" ::: "memory"); __syncthreads();
        if (tid < 16) { unsigned old = 0; if (tid == 0) old = __hip_atomic_fetch_add(cntS2, 1u, __ATOMIC_RELAXED, __HIP_MEMORY_SCOPE_AGENT);
            old = __builtin_amdgcn_readfirstlane(old);
            if (old == 63u) __hip_atomic_store(cnt5 + 64 * (90 + tid), 1u, __ATOMIC_RELAXED, __HIP_MEMORY_SCOPE_AGENT); }
    }
    { PHASE_IDS(); (void)gw;
        Unit u; prompt_unit(bx, 4, u);
        if (tid < 64) { unsigned sp = 0;
            for (;;) { const bool rdy = lane >= 2 || (lane == 1 && jq == 0) || __hip_atomic_load(cntG3 + 64 * (u.pm - lane), __ATOMIC_RELAXED, __HIP_MEMORY_SCOPE_AGENT) >= 16u;
                if (__all(rdy)) break; __builtin_amdgcn_s_sleep(8); if (++sp > (1u << 19)) break; }
            __builtin_amdgcn_fence(__ATOMIC_ACQUIRE, "agent"); asm volatile("s_waitcnt vmcnt(0)" ::: "memory"); }
        __syncthreads();
        const int e = tid * 4, wsh = wave >> 1;
#pragma unroll 1
        for (int j = 0; j < 2; ++j) { const int r = 2 * u.pm + j;
            if (wsh == 0) pool_fix_run<2>(r, e, HV, PV, PSZ, BB); else if (wsh == 1) pool_fix_run<4>(r, e, HV, PV, PSZ, BB);
            else if (wsh == 2) pool_fix_run<8>(r, e, HV, PV, PSZ, BB); else pool_fix_run<16>(r, e, HV, PV, PSZ, BB); }
        asm volatile("s_waitcnt vmcnt(0)" ::: "memory"); __syncthreads();
    }
    {
        pg8::Gemm g{BB, W5T, M, D, E, E, 0, 0, E, 0, 0}; SchedG5 S{bx};
        EpiG5 Ep{XB, (float*)(ws + WS_SCV), cnt5, fin_g, out + O_Y, lds + pg8::STAGE_BYTES + 4096, lds};
        pg8::gemm_phase<EpiG5, SchedG5, true, true, 0>(lds, g, S, Ep);
    }
    { const int tl = jq >= 4 ? (jq - 4) * 32 + (bx >> 6) * 8 + (bx & 7) : -1;
      if (tl >= 0) { PHASE_IDS(); (void)gw;
        if (tid < 64) { unsigned sp = 0;
            for (;;) { const bool rdy = lane >= 3 || __hip_atomic_load(lane == 0 ? cnt5 + 64 * (90 + (bx & 15)) : cnt2 + 64 * (63 + lane), __ATOMIC_RELAXED, __HIP_MEMORY_SCOPE_AGENT) >= (lane == 0 ? 1u : 4u);
                if (__all(rdy)) break; __builtin_amdgcn_s_sleep(32); if (++sp > (1u << 18)) break; }
            __builtin_amdgcn_fence(__ATOMIC_ACQUIRE, "agent"); asm volatile("s_waitcnt vmcnt(0)" ::: "memory"); }
        __syncthreads();
        const int tm = tl >> 4, tn = tl & 15, fr = lane & 15, fq = lane >> 4;
        const bf16_t* Ap = BB + (size_t)(MP + 64 * tm + fr) * E + 256 * wave + 8 * fq;
        const bf16_t* Bp[4];
#pragma unroll
        for (int n = 0; n < 4; ++n) Bp[n] = W5T + (size_t)dest_row(2, 64 * tn + 16 * n + fr) * E + 256 * wave + 8 * fq;
        f32x4 acc[4][4];
#pragma unroll
        for (int m = 0; m < 4; ++m)
#pragma unroll
            for (int n = 0; n < 4; ++n) acc[m][n] = (f32x4){0.f, 0.f, 0.f, 0.f};
#pragma unroll
        for (int hf = 0; hf < 2; ++hf) {
            bf16x8 af[4][4], bfr[4][4];
#pragma unroll
            for (int kk = 0; kk < 4; ++kk) {
#pragma unroll
                for (int m = 0; m < 4; ++m) af[m][kk] = *(const bf16x8*)(Ap + (size_t)(16 * m) * E + 32 * (4 * hf + kk));
#pragma unroll
                for (int n = 0; n < 4; ++n) bfr[n][kk] = *(const bf16x8*)(Bp[n] + 32 * (4 * hf + kk));
            }
#pragma unroll
            for (int kk = 0; kk < 4; ++kk)
#pragma unroll
                for (int m = 0; m < 4; ++m)
#pragma unroll
                    for (int n = 0; n < 4; ++n) acc[m][n] = __builtin_amdgcn_mfma_f32_16x16x32_bf16(bfr[n][kk], af[m][kk], acc[m][n], 0, 0, 0);
        }
        LAS f32x4* red = (LAS f32x4*)lds;
#pragma unroll
        for (int m = 0; m < 4; ++m)
#pragma unroll
            for (int n = 0; n < 4; ++n) red[(wave * 16 + m * 4 + n) * 64 + lane] = acc[m][n];
        __syncthreads();
#pragma unroll
        for (int q = 0; q < 2; ++q) { const int blk = wave * 2 + q, m = blk >> 2, n = blk & 3;
            f32x4 sm = red[blk * 64 + lane];
#pragma unroll
            for (int w = 1; w < 8; ++w) sm += red[(w * 16 + blk) * 64 + lane];
            const int rs = 64 * tm + 16 * m + fr, col = 64 * tn + 16 * n + 4 * fq;
            const u32x2 xw = *(const u32x2*)(XB + (size_t)(MP + rs) * D + col);
            sm[0] += bflo(xw.x); sm[1] += bfhi(xw.x); sm[2] += bflo(xw.y); sm[3] += bfhi(xw.y);
            st16_wt(mk_rsrc(SLAB, (unsigned)((size_t)MS * D * 4)), (unsigned)(((size_t)rs * D + col) * 4), __builtin_bit_cast(u32x4, sm)); }
        asm volatile("s_waitcnt vmcnt(0)" ::: "memory"); __syncthreads();
        if (tid < 16) { unsigned old = 0; if (tid == 0) old = __hip_atomic_fetch_add(cntSL, 1u, __ATOMIC_RELAXED, __HIP_MEMORY_SCOPE_AGENT);
            old = __builtin_amdgcn_readfirstlane(old);
            if (old == 127u) __hip_atomic_store(cnt5 + 64 * (106 + tid), 1u, __ATOMIC_RELAXED, __HIP_MEMORY_SCOPE_AGENT); }
      } }
    if (jq >= 6) { PHASE_IDS(); (void)gw;
        if (tid < 64) { unsigned sp = 0;
            while (__hip_atomic_load(cnt5 + 64 * (106 + (bx & 15)), __ATOMIC_RELAXED, __HIP_MEMORY_SCOPE_AGENT) < 1u) { __builtin_amdgcn_s_sleep(32); if (++sp > (1u << 18)) break; }
            __builtin_amdgcn_fence(__ATOMIC_ACQUIRE, "agent"); asm volatile("s_waitcnt vmcnt(0)" ::: "memory"); }
        __syncthreads();
        const int row = MP + ((jq - 6) * 32 + (bx >> 6) * 8 + (bx & 7)) * 8 + wave;
        f32x4 ga[2], gb[2];
#pragma unroll
        for (int j = 0; j < 2; ++j) { ga[j] = *(const f32x4*)(fin_g + (64 * j + lane) * 8); gb[j] = *(const f32x4*)(fin_g + (64 * j + lane) * 8 + 4); }
        float v[2][8]; float a = 0.f;
#pragma unroll
        for (int j = 0; j < 2; ++j) { const float* sp = SLAB + (size_t)(row - MP) * D + (64 * j + lane) * 8;
            const f32x4 s0 = *(const f32x4*)sp, s1 = *(const f32x4*)(sp + 4);
#pragma unroll
            for (int e = 0; e < 4; ++e) { v[j][e] = s0[e]; v[j][4 + e] = s1[e]; }
#pragma unroll
            for (int e = 0; e < 8; ++e) a += v[j][e] * v[j][e]; }
        const float r = rsqrtf(wave_sum(a) * (1.0f / D) + EPS);
#pragma unroll
        for (int j = 0; j < 2; ++j) {
            const f32x4 o0 = (f32x4){v[j][0], v[j][1], v[j][2], v[j][3]} * r * ga[j], o1 = (f32x4){v[j][4], v[j][5], v[j][6], v[j][7]} * r * gb[j];
            float* yr = out + O_Y + (size_t)row * D;
            *(f32x4*)(yr + (64 * j + lane) * 8) = o0; *(f32x4*)(yr + (64 * j + lane) * 8 + 4) = o1; }
    }
}

constexpr int LDS_BYTES = 147456;
extern "C" void kernel_launch(void* const* d_in, const int* in_sizes, int n_in, void* d_out, int out_size, void* d_ws, size_t ws_size, hipStream_t stream) {
    static int grid_blocks = 0;
    if (grid_blocks == 0) {
        if (n_in != 14 || ws_size < WS_END) { fprintf(stderr, "kernel_launch: unexpected problem (n_in %d, ws %zu)\n", n_in, ws_size); grid_blocks = -1; return; }
        int dev = 0, cus = 0, per_cu = 0;
        (void)hipGetDevice(&dev);
        (void)hipDeviceGetAttribute(&cus, hipDeviceAttributeMultiprocessorCount, dev);
        if (hipFuncSetAttribute((const void*)fwd_kernel, hipFuncAttributeMaxDynamicSharedMemorySize, LDS_BYTES) != hipSuccess) { fprintf(stderr, "kernel_launch: hipFuncSetAttribute failed\n"); grid_blocks = -1; return; }
        if (hipOccupancyMaxActiveBlocksPerMultiprocessor(&per_cu, (const void*)fwd_kernel, 512, LDS_BYTES) != hipSuccess || per_cu < 1) { fprintf(stderr, "kernel_launch: occupancy query failed or reports %d workgroups per CU; nothing launched\n", per_cu); (void)hipGetLastError(); grid_blocks = -1; return; }
        grid_blocks = cus * 1;
        if (grid_blocks != 256) { fprintf(stderr, "kernel_launch: built for a 256-CU device (static schedules), found %d CUs\n", cus); grid_blocks = -1; return; }
        fprintf(stderr, "kernel_launch: %d CUs, occupancy %d/CU, grid %d\n", cus, per_cu, grid_blocks);
    }
    if (grid_blocks < 0) return;
    (void)hipMemsetAsync((char*)d_ws + WS_CTL, 0, 262144, stream);
    Args a{};
    for (int i = 0; i < 14; ++i) a.in[i] = (const float*)d_in[i];
    a.out = (float*)d_out; a.ws = (unsigned char*)d_ws;
    void* args[] = {&a};
    hipError_t e = hipLaunchCooperativeKernel((const void*)fwd_kernel, dim3(grid_blocks), dim3(512), args, LDS_BYTES, stream);
    if (e != hipSuccess) fprintf(stderr, "cooperative launch failed: %s (grid %d)\n", hipGetErrorString(e), grid_blocks);
}
```
